# Optimizing an MI355X kernel written in HIP

```python
import math
import jax, jax.numpy as jnp
from jax import lax
import numpy as np

D_MODEL = 1024
BATCH = 16
SEQ = 256
DEPTH = 1
DEC_BATCH = 8
DEC_SEQ = 2048
PAST_LEN = 512

GRID_W = 64
EPS = 1e-6
A_HEADS = 4
A_HEAD_DIM = 128
A_WIDTH = A_HEADS * A_HEAD_DIM
CHUNK = 128
MLA_HEADS = 4
QK_NOPE = 128
QK_ROPE = 64
V_HEAD = 128
B_WIDTH = MLA_HEADS * V_HEAD
Q_RANK = 256
KV_RANK = 128
AXIS_PAIRS = QK_ROPE // 4
ROPE_THETA = 10000.0
Q_BLOCK = 128
ATTN_SCALE = 1.0 / math.sqrt(QK_NOPE + QK_ROPE)
IN_WIDTHS = (A_WIDTH, A_WIDTH, A_WIDTH, Q_RANK, KV_RANK, QK_ROPE, B_WIDTH)
IN_WIDTH = 3 * A_WIDTH + Q_RANK + KV_RANK + QK_ROPE + B_WIDTH
MIX_WIDTH = A_WIDTH + B_WIDTH

kernel_name = 'hymba_chunkmlp_mla_diffusion_step'


def _rmsnorm(x, g):
    xf = x.astype(jnp.float32)
    y = xf * lax.rsqrt(jnp.mean(xf * xf, axis=-1, keepdims=True) + EPS)
    return (y * g.astype(jnp.float32)).astype(x.dtype)


def _split_in(z):
    idx = [int(i) for i in np.cumsum(IN_WIDTHS)[:-1]]
    return jnp.split(z, idx, axis=-1)


def _grid_rope(n_tokens, dtype):
    rows = n_tokens // GRID_W
    r, cc = jnp.meshgrid(jnp.arange(rows), jnp.arange(GRID_W), indexing='ij')
    r = r.reshape(-1).astype(jnp.float32)
    cc = cc.reshape(-1).astype(jnp.float32)
    inv = ROPE_THETA ** (-jnp.arange(AXIS_PAIRS, dtype=jnp.float32) / AXIS_PAIRS)
    ang = jnp.concatenate([r[:, None] * inv, cc[:, None] * inv], axis=-1)
    return jnp.cos(ang).astype(dtype), jnp.sin(ang).astype(dtype)


def _rope(x, cos, sin):
    half = QK_ROPE // 2
    x1, x2 = x[..., :half], x[..., half:]
    return jnp.concatenate([x1 * cos - x2 * sin, x1 * sin + x2 * cos], axis=-1)


def _chunk_mlp(u, v, w_s, b_s, g_v):
    B, L, _ = u.shape
    n = L // CHUNK
    u = jax.nn.gelu(u)
    v = _rmsnorm(jax.nn.gelu(v).reshape(B, L, A_HEADS, A_HEAD_DIM), g_v)
    v = v.reshape(B, n, CHUNK, A_HEADS, A_HEAD_DIM)
    mixed = jnp.einsum('hpq,bnqhd->bnphd', w_s, v) + b_s.T[:, :, None]
    return u * mixed.reshape(B, L, A_WIDTH)


def _expand_kv(ckv, w_ukv):
    B, L, _ = ckv.shape
    kv = (ckv @ w_ukv).reshape(B, L, MLA_HEADS, QK_NOPE + V_HEAD)
    return kv[..., :QK_NOPE], kv[..., QK_NOPE:]


def _block_attention(q_nope, q_ropes, key_sets):
    B, Lq, H, _ = q_nope.shape
    nb = Lq // Q_BLOCK
    v_all = jnp.concatenate([ks[2] for ks in key_sets], axis=1)

    def one_block(i):
        s0 = i * Q_BLOCK
        qn = lax.dynamic_slice_in_dim(q_nope, s0, Q_BLOCK, axis=1)
        logits = []
        for qr, (kn, kr, _) in zip(q_ropes, key_sets):
            qrb = lax.dynamic_slice_in_dim(qr, s0, Q_BLOCK, axis=1)
            logits.append(jnp.einsum('bqhn,bkhn->bhqk', qn, kn)
                          + jnp.einsum('bqhr,bkr->bhqk', qrb, kr))
        s = jnp.concatenate(logits, axis=-1).astype(jnp.float32) * ATTN_SCALE
        p = jax.nn.softmax(s, axis=-1).astype(v_all.dtype)
        return jnp.einsum('bhqk,bkhv->bqhv', p, v_all)

    out = lax.map(one_block, jnp.arange(nb))
    return jnp.moveaxis(out, 0, 1).reshape(B, Lq, H * V_HEAD)


def _front(x, cond, norm_g, w_ada, b_ada, w_in, w_s, b_s, g_v, q_norm_g, w_uq, kv_norm_g):
    B, L, _ = x.shape
    mod = jax.nn.silu(cond) @ w_ada + b_ada
    shift, scale, gate = jnp.split(mod[:, None, :], 3, axis=-1)
    h = _rmsnorm(x, norm_g) * (1 + scale) + shift
    u, v, g_a, c_q, c_kv, k_rope, g_b = _split_in(h @ w_in)
    a_out = _chunk_mlp(u, v, w_s, b_s, g_v) * jax.nn.silu(g_a)
    q = (_rmsnorm(c_q, q_norm_g) @ w_uq).reshape(B, L, MLA_HEADS, QK_NOPE + QK_ROPE)
    ckv = _rmsnorm(c_kv, kv_norm_g)
    return gate, a_out, g_b, q[..., :QK_NOPE], q[..., QK_NOPE:], ckv, k_rope


def _back(x, gate, a_out, attn, g_b, w_o):
    y = jnp.concatenate([a_out, attn * jax.nn.silu(g_b)], axis=-1) @ w_o
    return x + gate * y


def setup_inputs(seed: int = 0) -> dict:
    key = jax.random.key(seed)
    ks = jax.random.split(key, 20)

    def nrm(k, shape, scale=1.0):
        return jax.random.normal(k, shape, jnp.float32) * scale

    return {
        'x_prompt': nrm(ks[0], (BATCH, SEQ, D_MODEL)),
        'x_sample': nrm(ks[1], (DEC_BATCH, DEC_SEQ, D_MODEL)),
        'cache_ckv': nrm(ks[2], (DEC_BATCH, DEPTH, PAST_LEN, KV_RANK)),
        'cache_krope': nrm(ks[3], (DEC_BATCH, DEPTH, PAST_LEN, QK_ROPE)),
        'c': nrm(ks[4], (DEC_BATCH, D_MODEL)),
        'c_ctx': nrm(ks[5], (D_MODEL,)),
        'norm_g': 1.0 + nrm(ks[6], (DEPTH, D_MODEL), 0.02),
        'w_ada': nrm(ks[7], (DEPTH, D_MODEL, 3 * D_MODEL), D_MODEL ** -0.5),
        'b_ada': nrm(ks[8], (DEPTH, 3 * D_MODEL), 0.01),
        'w_in': nrm(ks[9], (DEPTH, D_MODEL, IN_WIDTH), D_MODEL ** -0.5),
        'w_s': nrm(ks[10], (DEPTH, A_HEADS, CHUNK, CHUNK), CHUNK ** -0.5),
        'b_s': nrm(ks[11], (DEPTH, A_HEADS, CHUNK), 0.02),
        'g_v': 1.0 + nrm(ks[12], (DEPTH, A_HEADS, A_HEAD_DIM), 0.02),
        'q_norm_g': 1.0 + nrm(ks[13], (DEPTH, Q_RANK), 0.02),
        'w_uq': nrm(ks[14], (DEPTH, Q_RANK, MLA_HEADS * (QK_NOPE + QK_ROPE)), Q_RANK ** -0.5),
        'kv_norm_g': 1.0 + nrm(ks[15], (DEPTH, KV_RANK), 0.02),
        'w_ukv': nrm(ks[16], (DEPTH, KV_RANK, MLA_HEADS * (QK_NOPE + V_HEAD)), KV_RANK ** -0.5),
        'w_o': nrm(ks[17], (DEPTH, MIX_WIDTH, D_MODEL), MIX_WIDTH ** -0.5),
        'final_g': 1.0 + nrm(ks[18], (D_MODEL,), 0.02),
    }


def reference(x_prompt, x_sample, cache_ckv, cache_krope, c, c_ctx, norm_g, w_ada, b_ada,
              w_in, w_s, b_s, g_v, q_norm_g, w_uq, kv_norm_g, w_ukv, w_o, final_g):
    xp, xs = x_prompt, x_sample
    cos, sin = _grid_rope(x_sample.shape[1], x_sample.dtype)
    new_ckv, new_kr = [], []
    for l in range(DEPTH):
        p = (norm_g[l], w_ada[l], b_ada[l], w_in[l], w_s[l], b_s[l], g_v[l],
             q_norm_g[l], w_uq[l], kv_norm_g[l])
        gate, a_out, g_b, qn, qr, ckv, kr = _front(xp, c_ctx[None, :], *p)
        kn, vv = _expand_kv(ckv, w_ukv[l])
        attn = _block_attention(qn, (qr,), ((kn, kr, vv),))
        xp = _back(xp, gate, a_out, attn, g_b, w_o[l])
        new_ckv.append(ckv)
        new_kr.append(kr)
        gate, a_out, g_b, qn, qr, ckv, kr = _front(xs, c, *p)
        kn, vv = _expand_kv(ckv, w_ukv[l])
        ckv_c = cache_ckv[:, l]
        kn_c, v_c = _expand_kv(ckv_c, w_ukv[l])
        kr_c = cache_krope[:, l]
        qr_rot = _rope(qr, cos[:, None, :], sin[:, None, :])
        kr_rot = _rope(kr, cos, sin)
        attn = _block_attention(qn, (qr_rot, qr), ((kn, kr_rot, vv), (kn_c, kr_c, v_c)))
        xs = _back(xs, gate, a_out, attn, g_b, w_o[l])
    y_prompt = _rmsnorm(xp, final_g)
    y_sample = _rmsnorm(xs, final_g)
    return (y_prompt, y_sample, jnp.stack(new_ckv, axis=1), jnp.stack(new_kr, axis=1))
```

```cpp
#include <hip/hip_runtime.h>
#include <hip/hip_cooperative_groups.h>
#include <cstdio>
namespace cg = cooperative_groups;

typedef unsigned short u16;
using bf16x8 = __attribute__((ext_vector_type(8))) short;
using s16x4  = __attribute__((ext_vector_type(4))) short;
using f32x4  = __attribute__((ext_vector_type(4))) float;
using f32x16 = __attribute__((ext_vector_type(16))) float;
using u32x4  = __attribute__((ext_vector_type(4))) unsigned;
#define DI __device__ __forceinline__

constexpr int NT = 256;
constexpr int NTOK = 20480;
constexpr int NCTX = 4096;
constexpr int DM = 1024;
constexpr int ZW = 2560;
constexpr int INW = 2496;
constexpr float EPSF = 1e-6f;
constexpr float QSCALE = 0.07216878364870322f * 1.4426950408889634f;

constexpr size_t OFF_MOD   = 0;
constexpr size_t OFF_WINT  = OFF_MOD   + 9 * 3072 * 4;
constexpr size_t OFF_WOT   = OFF_WINT  + (size_t)ZW * 1024 * 2;
constexpr size_t OFF_WQT   = OFF_WOT   + (size_t)1024 * 1024 * 2;
constexpr size_t OFF_WKVT  = OFF_WQT   + (size_t)768 * 256 * 2;
constexpr size_t OFF_WSB   = OFF_WKVT  + (size_t)1024 * 128 * 2;
constexpr size_t OFF_ROPE  = OFF_WSB   + (size_t)4 * 128 * 128 * 2;
constexpr size_t OFF_H     = OFF_ROPE  + (size_t)2048 * 32 * 2 * 4;
constexpr size_t OFF_Z     = OFF_H     + (size_t)NTOK * 1024 * 2;
constexpr size_t OFF_Q     = OFF_Z     + (size_t)NTOK * ZW * 2;
constexpr size_t OFF_KC    = OFF_Q     + (size_t)NTOK * 768 * 2;
constexpr size_t OFF_VTC   = OFF_KC    + (size_t)16 * 256 * 192 * 2;
constexpr size_t OFF_KS    = OFF_VTC   + (size_t)16 * 128 * 256 * 2;
constexpr size_t OFF_VTS   = OFF_KS    + (size_t)8 * 2560 * 192 * 2;
constexpr size_t OFF_OLAT  = OFF_VTS   + (size_t)8 * 128 * 2560 * 2;
constexpr size_t OFF_SS    = OFF_OLAT  + (size_t)NTOK * 512 * 2;
constexpr size_t OFF_BAR   = OFF_SS    + (size_t)NTOK * 16 * 4;
constexpr size_t OFF_CNT   = OFF_BAR   + 3456 * 4;
constexpr size_t WS_TOTAL  = OFF_CNT   + 256 * 4;

struct Params {
  const float *x_prompt, *x_sample, *cache_ckv, *cache_krope, *c, *c_ctx, *norm_g, *w_ada, *b_ada, *w_in, *w_s, *b_s,
      *g_v, *q_norm_g, *w_uq, *kv_norm_g, *w_ukv, *w_o, *final_g;
  float* out;
  char* ws;
};

typedef float f32x2_t __attribute__((ext_vector_type(2)));
DI float max3f(float a, float b, float c) { float r; asm("v_max3_f32 %0, %1, %2, %3" : "=v"(r) : "v"(a), "v"(b), "v"(c)); return r; }
DI float max3f_after_mfma(float a, float b, float c) { float r; asm volatile("s_nop 11\n\tv_max3_f32 %0, %1, %2, %3" : "=v"(r) : "v"(a), "v"(b), "v"(c)); return r; }
DI int opaque_tid() { int t = threadIdx.x; asm volatile("" : "+v"(t)); return t; }
typedef __bf16 bf16x2_t __attribute__((ext_vector_type(2)));
typedef float f32x2c_t __attribute__((ext_vector_type(2)));
DI unsigned pack2(float a, float b) { f32x2c_t v = {a, b}; return __builtin_bit_cast(unsigned, __builtin_convertvector(v, bf16x2_t)); }
DI u16 f2bf(float x) { return (u16)(pack2(x, 0.f) & 0xffffu); }
DI float bf2f(u16 v) { return __uint_as_float(((unsigned)v) << 16); }
DI float gelu_f(float x) { float u = 0.7978845608028654f * (x + 0.044715f * x * x * x); return x * __builtin_amdgcn_rcpf(1.f + __expf(-2.f * u)); }
DI float silu_f(float x) { return x * __builtin_amdgcn_rcpf(1.f + __expf(-x)); }
DI const float* xrow(const Params& p, int t) { return t < NCTX ? p.x_prompt + (size_t)t * DM : p.x_sample + (size_t)(t - NCTX) * DM; }
DI int cond_of(int t) { return t < NCTX ? 8 : ((t - NCTX) >> 11); }

#define MFMA16(a, b, c) __builtin_amdgcn_mfma_f32_16x16x32_bf16((a), (b), (c), 0, 0, 0)
#define MFMA32(a, b, c) __builtin_amdgcn_mfma_f32_32x32x16_bf16((a), (b), (c), 0, 0, 0)

DI int lds_byte(int r, int c) {
  int st = (r >> 4) * 2 + (c >> 5), rr = r & 15, cc = c & 31, ob = rr * 64 + cc * 2;
  return st * 1024 + (ob ^ (((ob >> 9) & 1) << 5));
}
DI void stage_rc(int b, int& R, int& C) {
  int st = b >> 10, sb = b & 1023, swz = sb ^ (((sb >> 9) & 1) << 5);
  R = (st >> 1) * 16 + (swz >> 6); C = (st & 1) * 32 + ((swz & 63) >> 1);
}

DI void gemm_stage(const u16* A, int lda, const u16* Bt, int ldb, int kt, char* buf, int tid) {
#pragma unroll
  for (int i = 0; i < 4; ++i) {
    int b = tid * 16 + i * 4096, r, c; stage_rc(b, r, c);
    __builtin_amdgcn_global_load_lds((const unsigned*)(A + (size_t)r * lda + kt * 64 + c), (unsigned*)(buf + b), 16, 0, 0);
    __builtin_amdgcn_global_load_lds((const unsigned*)(Bt + (size_t)r * ldb + kt * 64 + c), (unsigned*)(buf + 16384 + b), 16, 0, 0);
  }
}

DI void gemm_mainloop(const u16* A, int lda, const u16* Bt, int ldb, int K, char* smem, f32x4 (&acc)[4][4], bool staged0 = false, int tid_in = -1) {
  const int tid = tid_in < 0 ? (int)threadIdx.x : tid_in, wid = tid >> 6, lane = tid & 63, wr = wid >> 1, wc = wid & 1, fr = lane & 15, fq = lane >> 4;
#pragma unroll
  for (int m = 0; m < 4; ++m)
#pragma unroll
    for (int n = 0; n < 4; ++n) acc[m][n] = f32x4{0.f, 0.f, 0.f, 0.f};
  const int nt = K >> 6;
  if (!staged0) gemm_stage(A, lda, Bt, ldb, 0, smem, tid);
  for (int t = 0; t < nt; ++t) {
    asm volatile("s_waitcnt vmcnt(0)" ::: "memory");
    __syncthreads();
    if (t + 1 < nt) gemm_stage(A, lda, Bt, ldb, t + 1, smem + ((t + 1) & 1) * 32768, tid);
    const char* sa = smem + (t & 1) * 32768;
    const char* sb = sa + 16384;
#pragma unroll
    for (int k = 0; k < 2; ++k) {
      bf16x8 af[4], bfr[4];
#pragma unroll
      for (int m = 0; m < 4; ++m) af[m] = *reinterpret_cast<const bf16x8*>(sa + lds_byte(wr * 64 + m * 16 + fr, k * 32 + fq * 8));
#pragma unroll
      for (int n = 0; n < 4; ++n) bfr[n] = *reinterpret_cast<const bf16x8*>(sb + lds_byte(wc * 64 + n * 16 + fr, k * 32 + fq * 8));
#pragma unroll
      for (int m = 0; m < 4; ++m)
#pragma unroll
        for (int n = 0; n < 4; ++n) acc[m][n] = MFMA16(af[m], bfr[n], acc[m][n]);
    }
  }
  __syncthreads();
}

DI void store_tile_bf16(f32x4 (&acc)[4][4], char* smem, u16* dst, int ldc, const float* rowscale, int tid_in = -1) {
  const int tid = tid_in < 0 ? (int)threadIdx.x : tid_in, wid = tid >> 6, lane = tid & 63, wr = wid >> 1, wc = wid & 1, fr = lane & 15, fq = lane >> 4;
  u16* st = reinterpret_cast<u16*>(smem);
#pragma unroll
  for (int m = 0; m < 4; ++m)
#pragma unroll
    for (int j = 0; j < 4; ++j) {
      int row = wr * 64 + m * 16 + fq * 4 + j;
      float rs = rowscale ? rowscale[row] : 1.f;
#pragma unroll
      for (int n = 0; n < 4; ++n) st[row * 136 + wc * 64 + n * 16 + fr] = f2bf(acc[m][n][j] * rs);
    }
  __syncthreads();
#pragma unroll
  for (int i = 0; i < 8; ++i) {
    int c = tid + i * 256, row = c >> 4, off = c & 15;
    *reinterpret_cast<uint4*>(dst + (size_t)row * ldc + off * 8) = *reinterpret_cast<const uint4*>(smem + row * 272 + off * 16);
  }
  __syncthreads();
}

DI void prep_mod(const Params& p, int unit, float* sm) {
  const int tid = threadIdx.x;
  for (int e = tid; e < 9 * 1024; e += NT) {
    int i = e >> 10, k = e & 1023;
    float v = (i < 8) ? p.c[i * 1024 + k] : p.c_ctx[k];
    sm[e] = silu_f(v);
  }
  __syncthreads();
  const int c4 = tid & 7, kg = tid >> 3, n0 = unit * 32 + c4 * 4;
  float acc[9][4];
#pragma unroll
  for (int i = 0; i < 9; ++i) { acc[i][0] = acc[i][1] = acc[i][2] = acc[i][3] = 0.f; }
#pragma unroll 4
  for (int j = 0; j < 32; ++j) {
    int k = j * 32 + kg;
    float4 w = *reinterpret_cast<const float4*>(p.w_ada + (size_t)k * 3072 + n0);
#pragma unroll
    for (int i = 0; i < 9; ++i) {
      float s = sm[i * 1024 + k];
      acc[i][0] += s * w.x; acc[i][1] += s * w.y; acc[i][2] += s * w.z; acc[i][3] += s * w.w;
    }
  }
  __syncthreads();
#pragma unroll
  for (int i = 0; i < 9; ++i)
#pragma unroll
    for (int e = 0; e < 4; ++e) sm[(kg * 36 + i * 4 + e) * 8 + c4] = acc[i][e];
  __syncthreads();
  float* mod = reinterpret_cast<float*>(p.ws + OFF_MOD);
  for (int o = tid; o < 288; o += NT) {
    int ie = o >> 3, cc = o & 7;
    float s = 0.f;
    for (int g = 0; g < 32; ++g) s += sm[(g * 36 + ie) * 8 + cc];
    int i = ie >> 2, e = ie & 3, n = unit * 32 + cc * 4 + e;
    mod[i * 3072 + n] = s + p.b_ada[n];
  }
  __syncthreads();
}

DI void transpose_unit(const float* src, int ldsrc, int ncols_valid, u16* dst, int lddst, int k0, int n0, float* sm) {
  const int tid = threadIdx.x;
  for (int e = tid; e < 64 * 16; e += NT) {
    int kk = e >> 4, c4 = e & 15, n = n0 + c4 * 4;
    float4 v = (n < ncols_valid) ? *reinterpret_cast<const float4*>(src + (size_t)(k0 + kk) * ldsrc + n) : make_float4(0.f, 0.f, 0.f, 0.f);
    float* d = sm + kk * 65 + c4 * 4;
    d[0] = v.x; d[1] = v.y; d[2] = v.z; d[3] = v.w;
  }
  __syncthreads();
  const int nn = tid >> 2, seg = tid & 3;
  unsigned w[8];
#pragma unroll
  for (int i = 0; i < 8; ++i) w[i] = pack2(sm[(seg * 16 + 2 * i) * 65 + nn], sm[(seg * 16 + 2 * i + 1) * 65 + nn]);
  uint4* o = reinterpret_cast<uint4*>(dst + (size_t)(n0 + nn) * lddst + k0 + seg * 16);
  o[0] = make_uint4(w[0], w[1], w[2], w[3]);
  o[1] = make_uint4(w[4], w[5], w[6], w[7]);
  __syncthreads();
}

DI void prep_wq(const Params& p, int unit) {
  const int c = threadIdx.x, h = unit / 192, r = unit % 192;
  const float g = p.q_norm_g[c] * QSCALE;
  float v;
  if (r < 128) {
    const float4* a = reinterpret_cast<const float4*>(p.w_uq + (size_t)c * 768 + h * 192);
    const float4* b = reinterpret_cast<const float4*>(p.w_ukv + (size_t)r * 1024 + h * 256);
    float s = 0.f;
#pragma unroll 8
    for (int j = 0; j < 32; ++j) { float4 x = a[j], y = b[j]; s += x.x * y.x + x.y * y.y + x.z * y.z + x.w * y.w; }
    v = s;
  } else {
    v = p.w_uq[(size_t)c * 768 + h * 192 + r];
  }
  reinterpret_cast<u16*>(p.ws + OFF_WQT)[unit * 256 + c] = f2bf(v * g);
}

DI void prep_cache(const Params& p, int unit, float* sm) {
  const int tid = threadIdx.x, b = unit >> 3, j0 = (unit & 7) * 64;
  u16* Ks = reinterpret_cast<u16*>(p.ws + OFF_KS) + (size_t)b * 2560 * 192;
  u16* VT = reinterpret_cast<u16*>(p.ws + OFF_VTS) + (size_t)b * 128 * 2560;
  const float* ck = p.cache_ckv + ((size_t)b * 512 + j0) * 128;
  const float* kr = p.cache_krope + ((size_t)b * 512 + j0) * 64;
  for (int e = tid; e < 64 * 32; e += NT) {
    int j = e >> 5, c4 = e & 31;
    float4 v = *reinterpret_cast<const float4*>(ck + (size_t)j * 128 + c4 * 4);
    float* d = sm + j * 129 + c4 * 4;
    d[0] = v.x; d[1] = v.y; d[2] = v.z; d[3] = v.w;
    uint2 o; o.x = pack2(v.x, v.y); o.y = pack2(v.z, v.w);
    *reinterpret_cast<uint2*>(Ks + (size_t)(2048 + j0 + j) * 192 + c4 * 4) = o;
  }
  for (int e = tid; e < 64 * 16; e += NT) {
    int j = e >> 4, c4 = e & 15;
    float4 v = *reinterpret_cast<const float4*>(kr + (size_t)j * 64 + c4 * 4);
    uint2 o; o.x = pack2(v.x, v.y); o.y = pack2(v.z, v.w);
    *reinterpret_cast<uint2*>(Ks + (size_t)(2048 + j0 + j) * 192 + 128 + c4 * 4) = o;
  }
  __syncthreads();
  const int r = tid >> 1, half = tid & 1;
  unsigned w[16];
#pragma unroll
  for (int i = 0; i < 16; ++i) w[i] = pack2(sm[(half * 32 + 2 * i) * 129 + r], sm[(half * 32 + 2 * i + 1) * 129 + r]);
  uint4* o = reinterpret_cast<uint4*>(VT + (size_t)r * 2560 + 2048 + j0 + half * 32);
#pragma unroll
  for (int i = 0; i < 4; ++i) o[i] = make_uint4(w[4 * i], w[4 * i + 1], w[4 * i + 2], w[4 * i + 3]);
  __syncthreads();
}

DI void phase_prep(const Params& p, char* smem) {
  float* sm = reinterpret_cast<float*>(smem);
  const int tid = threadIdx.x;
  for (int u = blockIdx.x; u < 1888; u += gridDim.x) {
    int v = u;
    if (v < 96) { prep_mod(p, v, sm); continue; }
    v -= 96;
    if (v < 640) { transpose_unit(p.w_in, INW, INW, reinterpret_cast<u16*>(p.ws + OFF_WINT), 1024, (v & 15) * 64, (v >> 4) * 64, sm); continue; }
    v -= 640;
    if (v < 256) { transpose_unit(p.w_o, 1024, 1024, reinterpret_cast<u16*>(p.ws + OFF_WOT), 1024, (v & 15) * 64, (v >> 4) * 64, sm); continue; }
    v -= 256;
    if (v < 768) { prep_wq(p, v); continue; }
    v -= 768;
    if (v < 32) { transpose_unit(p.w_ukv, 1024, 1024, reinterpret_cast<u16*>(p.ws + OFF_WKVT), 128, (v & 1) * 64, (v >> 1) * 64, sm); continue; }
    v -= 32;
    if (v < 16) {
      u16* d = reinterpret_cast<u16*>(p.ws + OFF_WSB);
      for (int e = v * 4096 + tid; e < (v + 1) * 4096; e += NT) d[e] = f2bf(p.w_s[e]);
      continue;
    }
    v -= 16;
    if (v < 64) { prep_cache(p, v, sm); continue; }
    v -= 64;
    {
      float* tc = reinterpret_cast<float*>(p.ws + OFF_ROPE);
      float* ts = tc + 2048 * 32;
      for (int e = v * 4096 + tid; e < (v + 1) * 4096; e += NT) {
        int pos = e >> 5, i = e & 31;
        float inv = powf(10000.f, -(float)(i & 15) / 16.f);
        float a = (float)((i < 16) ? (pos >> 6) : (pos & 63)) * inv;
        tc[e] = cosf(a); ts[e] = sinf(a);
      }
    }
  }
}

DI void phase_h(const Params& p) {
  const int lane = threadIdx.x & 63, wid = threadIdx.x >> 6;
  const float* mod = reinterpret_cast<const float*>(p.ws + OFF_MOD);
  u16* H = reinterpret_cast<u16*>(p.ws + OFF_H);
  for (int t = (blockIdx.x * 4 + wid) * 4; t < NTOK; t += gridDim.x * 16) {
    float4 v[4][4];
#pragma unroll
    for (int k = 0; k < 4; ++k) {
      const float* x = xrow(p, t + k);
#pragma unroll
      for (int j = 0; j < 4; ++j) v[k][j] = *reinterpret_cast<const float4*>(x + j * 256 + lane * 4);
    }
    const float* md = mod + cond_of(t) * 3072;
    float4 g[4], sh[4], sc[4];
#pragma unroll
    for (int j = 0; j < 4; ++j) {
      const int c = j * 256 + lane * 4;
      g[j] = *reinterpret_cast<const float4*>(p.norm_g + c);
      sh[j] = *reinterpret_cast<const float4*>(md + c);
      sc[j] = *reinterpret_cast<const float4*>(md + 1024 + c);
    }
#pragma unroll
    for (int k = 0; k < 4; ++k) {
      float ss = 0.f;
#pragma unroll
      for (int j = 0; j < 4; ++j) ss += v[k][j].x * v[k][j].x + v[k][j].y * v[k][j].y + v[k][j].z * v[k][j].z + v[k][j].w * v[k][j].w;
#pragma unroll
      for (int o = 32; o > 0; o >>= 1) ss += __shfl_xor(ss, o);
      const float rstd = rsqrtf(ss * (1.f / 1024.f) + EPSF);
#pragma unroll
      for (int j = 0; j < 4; ++j) {
        const int c = j * 256 + lane * 4;
        float a0 = v[k][j].x * rstd * g[j].x * (1.f + sc[j].x) + sh[j].x;
        float a1 = v[k][j].y * rstd * g[j].y * (1.f + sc[j].y) + sh[j].y;
        float a2 = v[k][j].z * rstd * g[j].z * (1.f + sc[j].z) + sh[j].z;
        float a3 = v[k][j].w * rstd * g[j].w * (1.f + sc[j].w) + sh[j].w;
        uint2 o; o.x = pack2(a0, a1); o.y = pack2(a2, a3);
        *reinterpret_cast<uint2*>(H + (size_t)(t + k) * 1024 + c) = o;
      }
    }
  }
}

DI void phase_gemm1(const Params& p, char* smem) {
  const u16* H = reinterpret_cast<const u16*>(p.ws + OFF_H);
  const u16* W = reinterpret_cast<const u16*>(p.ws + OFF_WINT);
  u16* Z = reinterpret_cast<u16*>(p.ws + OFF_Z);
  for (int u = blockIdx.x; u < 160 * 20; u += gridDim.x) {
    const int xcd = u & 7, iu = u >> 3;
    int mt = (iu / 20) * 8 + xcd, nt = iu % 20;
    f32x4 acc[4][4];
    gemm_mainloop(H + (size_t)mt * 128 * 1024, 1024, W + (size_t)nt * 128 * 1024, 1024, 1024, smem, acc);
    store_tile_bf16(acc, smem, Z + (size_t)mt * 128 * ZW + nt * 128, ZW, nullptr);
  }
}

DI void chunk_mlp_unit(const Params& p, int unit, char* smem) {
  const int tid = opaque_tid(), wid = tid >> 6, lane = tid & 63, fr = lane & 15, fq = lane >> 4;
  const int ck = unit >> 2, hh = unit & 3, t0 = ck * 128;
  const u16* Z = reinterpret_cast<const u16*>(p.ws + OFF_Z);
  u16* MIX = reinterpret_cast<u16*>(p.ws + OFF_H);
  u16* vnT = reinterpret_cast<u16*>(smem);
  {
    const int q = tid >> 1, half = tid & 1;
    const u16* src = Z + (size_t)(t0 + q) * ZW + 512 + hh * 128 + half * 64;
    float g[64];
    float ss = 0.f;
#pragma unroll
    for (int i = 0; i < 8; ++i) {
      bf16x8 v = *reinterpret_cast<const bf16x8*>(src + i * 8);
#pragma unroll
      for (int j = 0; j < 8; ++j) { float x = gelu_f(bf2f((u16)v[j])); g[i * 8 + j] = x; ss += x * x; }
    }
    ss += __shfl_xor(ss, 1);
    const float rstd = rsqrtf(ss * (1.f / 128.f) + EPSF);
    const float* gv = p.g_v + hh * 128 + half * 64;
#pragma unroll
    for (int i = 0; i < 64; ++i) vnT[(half * 64 + i) * 136 + q] = f2bf(g[i] * rstd * gv[i]);
  }
  __syncthreads();
  const u16* wsb = reinterpret_cast<const u16*>(p.ws + OFF_WSB) + hh * 16384;
  f32x4 acc[2][8];
#pragma unroll
  for (int m = 0; m < 2; ++m)
#pragma unroll
    for (int n = 0; n < 8; ++n) acc[m][n] = f32x4{0.f, 0.f, 0.f, 0.f};
#pragma unroll
  for (int ks = 0; ks < 4; ++ks) {
    bf16x8 a[2];
#pragma unroll
    for (int m = 0; m < 2; ++m) a[m] = *reinterpret_cast<const bf16x8*>(wsb + (wid * 32 + m * 16 + fr) * 128 + ks * 32 + fq * 8);
#pragma unroll
    for (int n = 0; n < 8; ++n) {
      bf16x8 b = *reinterpret_cast<const bf16x8*>(vnT + (n * 16 + fr) * 136 + ks * 32 + fq * 8);
#pragma unroll
      for (int m = 0; m < 2; ++m) acc[m][n] = MFMA16(a[m], b, acc[m][n]);
    }
  }
  bf16x8 uu[8], gg[8];
#pragma unroll
  for (int i = 0; i < 8; ++i) {
    const int c = tid + i * 256, row = c >> 4, col = (c & 15) * 8;
    const u16* zr = Z + (size_t)(t0 + row) * ZW + hh * 128 + col;
    uu[i] = *reinterpret_cast<const bf16x8*>(zr);
    gg[i] = *reinterpret_cast<const bf16x8*>(zr + 1024);
  }
  __syncthreads();
  float* stf = reinterpret_cast<float*>(smem);
#pragma unroll
  for (int m = 0; m < 2; ++m)
#pragma unroll
    for (int j = 0; j < 4; ++j) {
      const int pr = wid * 32 + m * 16 + fq * 4 + j;
      const float bs = p.b_s[hh * 128 + pr];
#pragma unroll
      for (int n = 0; n < 8; ++n) stf[pr * 128 + ((n * 16 + fr) ^ (fq * 16))] = acc[m][n][j] + bs;
    }
  __syncthreads();
#pragma unroll
  for (int i = 0; i < 8; ++i) {
    const int c = tid + i * 256, row = c >> 4, col = (c & 15) * 8, sw = ((row >> 2) & 3) * 16;
    const float4 m0 = *reinterpret_cast<const float4*>(stf + row * 128 + (col ^ sw));
    const float4 m1 = *reinterpret_cast<const float4*>(stf + row * 128 + ((col + 4) ^ sw));
    const float mm[8] = {m0.x, m0.y, m0.z, m0.w, m1.x, m1.y, m1.z, m1.w};
    float o8[8];
#pragma unroll
    for (int k = 0; k < 8; ++k) o8[k] = gelu_f(bf2f((u16)uu[i][k])) * mm[k] * silu_f(bf2f((u16)gg[i][k]));
    uint4 ov = make_uint4(pack2(o8[0], o8[1]), pack2(o8[2], o8[3]), pack2(o8[4], o8[5]), pack2(o8[6], o8[7]));
    *reinterpret_cast<uint4*>(MIX + (size_t)(t0 + row) * 1024 + hh * 128 + col) = ov;
  }
  __syncthreads();
}

DI void qproj_unit(const Params& p, int unit, char* smem) {
  const int tid = opaque_tid();
  const int mt = unit / 3, np = unit % 3;
  const u16* A = reinterpret_cast<const u16*>(p.ws + OFF_Z) + (size_t)mt * 128 * ZW + 1536;
  const u16* W = reinterpret_cast<const u16*>(p.ws + OFF_WQT) + (size_t)np * 256 * 256;
  float* rs = reinterpret_cast<float*>(smem + 65536 - 512);
  gemm_stage(A, ZW, W, 256, 0, smem, tid);
  float myrs;
  {
    const int row = tid >> 1, half = tid & 1;
    const u16* src = A + (size_t)row * ZW + half * 128;
    float ss = 0.f;
#pragma unroll
    for (int i = 0; i < 16; ++i) {
      bf16x8 v = *reinterpret_cast<const bf16x8*>(src + i * 8);
#pragma unroll
      for (int j = 0; j < 8; ++j) { float x = bf2f((u16)v[j]); ss += x * x; }
    }
    ss += __shfl_xor(ss, 1);
    myrs = rsqrtf(ss * (1.f / 256.f) + EPSF);
  }
#pragma unroll 1
  for (int h2 = 0; h2 < 2; ++h2) {
    f32x4 acc[4][4];
    gemm_mainloop(A, ZW, W + (size_t)h2 * 128 * 256, 256, 256, smem, acc, h2 == 0, tid);
    if ((tid & 1) == 0) rs[tid >> 1] = myrs;
    __syncthreads();
    store_tile_bf16(acc, smem, reinterpret_cast<u16*>(p.ws + OFF_Q) + (size_t)mt * 128 * 768 + (np * 2 + h2) * 128, 768, rs, tid);
  }
}

DI void kv_unit(const Params& p, int unit, char* smem) {
  const int tid = opaque_tid(), lane = tid & 63, wid = tid >> 6;
  const u16* Z = reinterpret_cast<const u16*>(p.ws + OFF_Z);
  const float* tc = reinterpret_cast<const float*>(p.ws + OFF_ROPE);
  const float* ts = tc + 2048 * 32;
  const float g0 = p.kv_norm_g[lane * 2], g1 = p.kv_norm_g[lane * 2 + 1];
  u16* tile = reinterpret_cast<u16*>(smem);
  const int t0 = unit * 64;
  const bool ctx = t0 < NCTX;
  const int b = ctx ? (t0 >> 8) : ((t0 - NCTX) >> 11), pos0 = ctx ? (t0 & 255) : ((t0 - NCTX) & 2047);
  const int ldv = ctx ? 256 : 2560;
  u16* Kb = ctx ? reinterpret_cast<u16*>(p.ws + OFF_KC) + (size_t)b * 256 * 192 : reinterpret_cast<u16*>(p.ws + OFF_KS) + (size_t)b * 2560 * 192;
  u16* VTb = ctx ? reinterpret_cast<u16*>(p.ws + OFF_VTC) + (size_t)b * 128 * 256 : reinterpret_cast<u16*>(p.ws + OFF_VTS) + (size_t)b * 128 * 2560;
  unsigned cvv[16]; u16 krv[16]; float csv[16], snv[16];
#pragma unroll
  for (int i = 0; i < 16; ++i) {
    const int tl = wid * 16 + i;
    const u16* zr = Z + (size_t)(t0 + tl) * ZW;
    cvv[i] = *reinterpret_cast<const unsigned*>(zr + 1792 + lane * 2);
    krv[i] = zr[1920 + lane];
    csv[i] = ctx ? 1.f : tc[(pos0 + tl) * 32 + (lane & 31)];
    snv[i] = ctx ? 0.f : ts[(pos0 + tl) * 32 + (lane & 31)];
  }
#pragma unroll
  for (int i = 0; i < 16; ++i) {
    const int tl = wid * 16 + i, t = t0 + tl, pos = pos0 + tl;
    float a0 = bf2f((u16)(cvv[i] & 0xffff)), a1 = bf2f((u16)(cvv[i] >> 16));
    float ss = a0 * a0 + a1 * a1;
#pragma unroll
    for (int o = 32; o > 0; o >>= 1) ss += __shfl_xor(ss, o);
    const float rstd = rsqrtf(ss * (1.f / 128.f) + EPSF);
    a0 *= rstd * g0; a1 *= rstd * g1;
    float kr = bf2f(krv[i]);
    if (ctx) {
      float* o_ckv = p.out + (size_t)NTOK * 1024 + (size_t)t * 128;
      float* o_kr = p.out + (size_t)NTOK * 1024 + (size_t)NCTX * 128 + (size_t)t * 64;
      *reinterpret_cast<float2*>(o_ckv + lane * 2) = make_float2(a0, a1);
      o_kr[lane] = kr;
    } else {
      float other = __shfl_xor(kr, 32);
      kr = (lane < 32) ? (kr * csv[i] - other * snv[i]) : (other * snv[i] + kr * csv[i]);
    }
    u16* Kd = Kb + (size_t)pos * 192;
    const unsigned pk = pack2(a0, a1);
    *reinterpret_cast<unsigned*>(Kd + lane * 2) = pk;
    Kd[128 + lane] = f2bf(kr);
    *reinterpret_cast<unsigned*>(tile + tl * 136 + lane * 2) = pk;
  }
  __syncthreads();
  {
    const int r = tid >> 1, half = tid & 1;
    unsigned w[16];
#pragma unroll
    for (int k = 0; k < 16; ++k)
      w[k] = (unsigned)tile[(half * 32 + 2 * k) * 136 + r] | ((unsigned)tile[(half * 32 + 2 * k + 1) * 136 + r] << 16);
    uint4* o = reinterpret_cast<uint4*>(VTb + (size_t)r * ldv + pos0 + half * 32);
#pragma unroll
    for (int k = 0; k < 4; ++k) o[k] = make_uint4(w[4 * k], w[4 * k + 1], w[4 * k + 2], w[4 * k + 3]);
  }
  __syncthreads();
}

DI void phase_local(const Params& p, char* smem) {
  for (int u = blockIdx.x; u < 1440; u += gridDim.x) {
    if (u < 640) chunk_mlp_unit(p, u, smem);
    else if (u < 1120) qproj_unit(p, u - 640, smem);
    else kv_unit(p, u - 1120, smem);
  }
}

DI bf16x8 pack_step(const f32x16& x, int s) {
  u32x4 r;
  asm volatile("v_cvt_pk_bf16_f32 %0, %4, %5\n\tv_cvt_pk_bf16_f32 %1, %6, %7\n\tv_cvt_pk_bf16_f32 %2, %8, %9\n\tv_cvt_pk_bf16_f32 %3, %10, %11\n\ts_nop 1"
               : "=&v"(r[0]), "=&v"(r[1]), "=&v"(r[2]), "=&v"(r[3])
               : "v"(x[8 * s]), "v"(x[8 * s + 1]), "v"(x[8 * s + 2]), "v"(x[8 * s + 3]), "v"(x[8 * s + 4]), "v"(x[8 * s + 5]), "v"(x[8 * s + 6]), "v"(x[8 * s + 7]));
  return __builtin_bit_cast(bf16x8, r);
}

constexpr int AK_BYTES = 32 * 384;
constexpr int ASTAGE = AK_BYTES;

DI void attn_unit(const Params& p, int unit, char* smem) {
  const int tid = threadIdx.x, w = tid >> 6, lane = tid & 63, r = lane & 31, hf = lane >> 5;
  int t0, nkt, nrot, ldv, pos0;
  const u16 *Kg, *VTg;
  if (unit < 512) {
    const int b = unit & 7, g = unit >> 3;
    t0 = NCTX + b * 2048 + g * 32; nkt = 80; nrot = 64; ldv = 2560; pos0 = g * 32;
    Kg = reinterpret_cast<const u16*>(p.ws + OFF_KS) + (size_t)b * 2560 * 192;
    VTg = reinterpret_cast<const u16*>(p.ws + OFF_VTS) + (size_t)b * 128 * 2560;
  } else {
    const int u2 = unit - 512, b = (u2 & 7) + 8 * ((u2 >> 3) & 1), g = u2 >> 4;
    t0 = b * 256 + g * 32; nkt = 8; nrot = 0; ldv = 256; pos0 = 0;
    Kg = reinterpret_cast<const u16*>(p.ws + OFF_KC) + (size_t)b * 256 * 192;
    VTg = reinterpret_cast<const u16*>(p.ws + OFF_VTC) + (size_t)b * 128 * 256;
  }
  const u16* qrow = reinterpret_cast<const u16*>(p.ws + OFF_Q) + (size_t)(t0 + r) * 768 + w * 192;
  bf16x8 qa[8], qr[4];
#pragma unroll
  for (int s = 0; s < 8; ++s) qa[s] = *reinterpret_cast<const bf16x8*>(qrow + 16 * s + 8 * hf);
#pragma unroll
  for (int s = 0; s < 4; ++s) qr[s] = *reinterpret_cast<const bf16x8*>(qrow + 128 + 16 * s + 8 * hf);
  if (nrot > 0) {
    const float* tc = reinterpret_cast<const float*>(p.ws + OFF_ROPE) + (size_t)(pos0 + r) * 32;
    const float* ts = tc + 2048 * 32;
#pragma unroll
    for (int s = 0; s < 2; ++s) {
      bf16x8 n1, n2;
#pragma unroll
      for (int j = 0; j < 8; ++j) {
        float x1 = bf2f((u16)qr[s][j]), x2 = bf2f((u16)qr[s + 2][j]);
        float cs = tc[16 * s + 8 * hf + j], sn = ts[16 * s + 8 * hf + j];
        n1[j] = (short)f2bf(x1 * cs - x2 * sn);
        n2[j] = (short)f2bf(x1 * sn + x2 * cs);
      }
      qr[s] = n1; qr[s + 2] = n2;
    }
  }
  int kg0, kg1, kg2;
  {
    const int L0 = tid, L1 = tid + 256, L2 = tid + 512;
    const int r0 = L0 / 24, c0 = L0 % 24, r1 = L1 / 24, c1 = L1 % 24, r2 = L2 / 24, c2 = L2 % 24;
    kg0 = r0 * 192 + ((c0 & ~7) | ((c0 & 7) ^ ((r0 >> 1) & 7))) * 8;
    kg1 = r1 * 192 + ((c1 & ~7) | ((c1 & 7) ^ ((r1 >> 1) & 7))) * 8;
    kg2 = r2 * 192 + ((c2 & ~7) | ((c2 & 7) ^ ((r2 >> 1) & 7))) * 8;
  }
#define ATT_ISSUE(kt, stage) do { char* sb_ = smem + (stage) * ASTAGE + tid * 16; const u16* kb_ = Kg + (size_t)(kt) * 32 * 192; \
    __builtin_amdgcn_global_load_lds((const unsigned*)(kb_ + kg0), (unsigned*)(sb_), 16, 0, 0); \
    __builtin_amdgcn_global_load_lds((const unsigned*)(kb_ + kg1), (unsigned*)(sb_ + 4096), 16, 0, 0); \
    __builtin_amdgcn_global_load_lds((const unsigned*)(kb_ + kg2), (unsigned*)(sb_ + 8192), 16, 0, 0); } while (0)
  const int ksw = (r >> 1) & 7;
  int koff[4];
#pragma unroll
  for (int j = 0; j < 4; ++j) koff[j] = r * 384 + (((2 * j + hf) ^ ksw) * 16);
  int vtoff[2];
  {
    const int i16 = lane & 15, q4 = i16 >> 2, p4 = i16 & 3, blk = (lane >> 4) & 1;
    const int sw0 = (2 * hf + (q4 >> 1)) & 7;
#pragma unroll
    for (int dl = 0; dl < 2; ++dl) vtoff[dl] = (4 * hf + q4) * 384 + (((4 * dl + 2 * blk + (p4 >> 1)) ^ sw0) * 16) + 8 * (p4 & 1);
  }
  f32x16 o[4];
#pragma unroll
  for (int dt = 0; dt < 4; ++dt)
#pragma unroll
    for (int i = 0; i < 16; ++i) o[dt][i] = 0.f;
  float mrun = 0.f, lrun = 0.f;
  f32x16 negm;
#pragma unroll
  for (int i = 0; i < 16; ++i) negm[i] = 0.f;
  asm volatile("" :: "v"(qa[0]), "v"(qa[1]), "v"(qa[2]), "v"(qa[3]), "v"(qa[4]), "v"(qa[5]), "v"(qa[6]), "v"(qa[7]),
               "v"(qr[0]), "v"(qr[1]), "v"(qr[2]), "v"(qr[3]));
  asm volatile("s_waitcnt vmcnt(0)" ::: "memory");
  ATT_ISSUE(0, 0);
  ATT_ISSUE(1, 1);
  int st = 0;
  int t = 0;
#pragma unroll 1
  for (int seg = 0; seg < 2; ++seg) {
  const int tend = (seg == 0) ? nrot : nkt;
  if (seg == 1 && nrot > 0) {
#pragma unroll
    for (int s4 = 0; s4 < 4; ++s4) qr[s4] = *reinterpret_cast<const bf16x8*>(qrow + 128 + 16 * s4 + 8 * hf);
    asm volatile("" :: "v"(qr[0]), "v"(qr[1]), "v"(qr[2]), "v"(qr[3]));
  }
#pragma unroll 1
  for (; t < tend; ++t) {
    if (t + 1 < nkt) asm volatile("s_waitcnt vmcnt(3)" ::: "memory");
    else asm volatile("s_waitcnt vmcnt(0)" ::: "memory");
    __builtin_amdgcn_s_barrier();
    if (t + 2 < nkt) { const int st2 = (st == 0) ? 2 : st - 1; ATT_ISSUE(t + 2, st2); }
    const char* Ks = smem + st * ASTAGE;
    st = (st == 2) ? 0 : st + 1;
    f32x16 s;
    const unsigned kb = (unsigned)(size_t)Ks;
    const unsigned ka0 = kb + koff[0], ka1 = kb + koff[1], ka2 = kb + koff[2], ka3 = kb + koff[3];
    const unsigned va0 = kb + vtoff[0], va1 = kb + vtoff[1];
    {
      bf16x8 k0, k1, k2, k3, k4, k5, k6, k7, k8, k9, k10, k11;
      asm volatile(
          "ds_read_b128 %0, %12\n\tds_read_b128 %1, %13\n\tds_read_b128 %2, %14\n\tds_read_b128 %3, %15\n\t"
          "ds_read_b128 %4, %12 offset:128\n\tds_read_b128 %5, %13 offset:128\n\tds_read_b128 %6, %14 offset:128\n\tds_read_b128 %7, %15 offset:128\n\t"
          "ds_read_b128 %8, %12 offset:256\n\tds_read_b128 %9, %13 offset:256\n\tds_read_b128 %10, %14 offset:256\n\tds_read_b128 %11, %15 offset:256\n\t"
          "s_waitcnt lgkmcnt(0)"
          : "=&v"(k0), "=&v"(k1), "=&v"(k2), "=&v"(k3), "=&v"(k4), "=&v"(k5), "=&v"(k6), "=&v"(k7), "=&v"(k8), "=&v"(k9), "=&v"(k10), "=&v"(k11)
          : "v"(ka0), "v"(ka1), "v"(ka2), "v"(ka3) : "memory");
      __builtin_amdgcn_s_setprio(1);
      s = MFMA32(k0, qa[0], negm); s = MFMA32(k1, qa[1], s); s = MFMA32(k2, qa[2], s); s = MFMA32(k3, qa[3], s);
      s = MFMA32(k4, qa[4], s); s = MFMA32(k5, qa[5], s); s = MFMA32(k6, qa[6], s); s = MFMA32(k7, qa[7], s);
      s = MFMA32(k8, qr[0], s); s = MFMA32(k9, qr[1], s); s = MFMA32(k10, qr[2], s); s = MFMA32(k11, qr[3], s);
      __builtin_amdgcn_s_setprio(0);
    }
    s16x4 v0, v1, v2, v3, v4, v5, v6, v7, v8, v9, v10, v11, v12, v13, v14, v15;
    asm volatile(
        "ds_read_b64_tr_b16 %0, %16\n\tds_read_b64_tr_b16 %1, %17 offset:3072\n\tds_read_b64_tr_b16 %2, %16 offset:6144\n\tds_read_b64_tr_b16 %3, %17 offset:9216\n\t"
        "ds_read_b64_tr_b16 %4, %17\n\tds_read_b64_tr_b16 %5, %16 offset:3072\n\tds_read_b64_tr_b16 %6, %17 offset:6144\n\tds_read_b64_tr_b16 %7, %16 offset:9216\n\t"
        "ds_read_b64_tr_b16 %8, %16 offset:128\n\tds_read_b64_tr_b16 %9, %17 offset:3200\n\tds_read_b64_tr_b16 %10, %16 offset:6272\n\tds_read_b64_tr_b16 %11, %17 offset:9344\n\t"
        "ds_read_b64_tr_b16 %12, %17 offset:128\n\tds_read_b64_tr_b16 %13, %16 offset:3200\n\tds_read_b64_tr_b16 %14, %17 offset:6272\n\tds_read_b64_tr_b16 %15, %16 offset:9344"
        : "=&v"(v0), "=&v"(v1), "=&v"(v2), "=&v"(v3), "=&v"(v4), "=&v"(v5), "=&v"(v6), "=&v"(v7),
          "=&v"(v8), "=&v"(v9), "=&v"(v10), "=&v"(v11), "=&v"(v12), "=&v"(v13), "=&v"(v14), "=&v"(v15)
        : "v"(va0), "v"(va1) : "memory");
    const float mA = max3f_after_mfma(s[0], s[1], s[2]);
    float mx = max3f(max3f(mA, max3f(s[3], s[4], s[5]), max3f(s[6], s[7], s[8])),
                     max3f(s[9], s[10], s[11]), max3f(max3f(s[12], s[13], s[14]), s[15], s[15]));
    {
      auto sw = __builtin_amdgcn_permlane32_swap(__float_as_uint(mx), __float_as_uint(mx), false, false);
      mx = fmaxf(__uint_as_float(sw[0]), __uint_as_float(sw[1]));
    }
    const bool first = (t == 0);
    if (first || __builtin_amdgcn_ballot_w64(mx > 8.f) != 0ull) {
      const float delta = first ? mx : fmaxf(mx, 0.f);
      mrun += delta;
#pragma unroll
      for (int i = 0; i < 16; ++i) { negm[i] = -mrun; s[i] -= delta; }
      if (!first) {
        const float alpha = __builtin_amdgcn_exp2f(-delta);
        lrun *= alpha;
#pragma unroll
        for (int dt = 0; dt < 4; ++dt)
#pragma unroll
          for (int i = 0; i < 16; ++i) o[dt][i] *= alpha;
      }
    }
    f32x2_t ps2 = {0.f, 0.f};
#pragma unroll
    for (int i = 0; i < 8; ++i) {
      const float e0 = __builtin_amdgcn_exp2f(s[2 * i]), e1 = __builtin_amdgcn_exp2f(s[2 * i + 1]);
      s[2 * i] = e0; s[2 * i + 1] = e1;
      ps2 += f32x2_t{e0, e1};
    }
    lrun += ps2[0] + ps2[1];
    bf16x8 pb[2];
    pb[0] = pack_step(s, 0);
    pb[1] = pack_step(s, 1);
    asm volatile("s_waitcnt lgkmcnt(0)"
                 : "+v"(v0), "+v"(v1), "+v"(v2), "+v"(v3), "+v"(v4), "+v"(v5), "+v"(v6), "+v"(v7),
                   "+v"(v8), "+v"(v9), "+v"(v10), "+v"(v11), "+v"(v12), "+v"(v13), "+v"(v14), "+v"(v15));
    __builtin_amdgcn_s_setprio(1);
    o[0] = MFMA32(__builtin_shufflevector(v0, v1, 0, 1, 2, 3, 4, 5, 6, 7), pb[0], o[0]);
    o[1] = MFMA32(__builtin_shufflevector(v4, v5, 0, 1, 2, 3, 4, 5, 6, 7), pb[0], o[1]);
    o[2] = MFMA32(__builtin_shufflevector(v8, v9, 0, 1, 2, 3, 4, 5, 6, 7), pb[0], o[2]);
    o[3] = MFMA32(__builtin_shufflevector(v12, v13, 0, 1, 2, 3, 4, 5, 6, 7), pb[0], o[3]);
    o[0] = MFMA32(__builtin_shufflevector(v2, v3, 0, 1, 2, 3, 4, 5, 6, 7), pb[1], o[0]);
    o[1] = MFMA32(__builtin_shufflevector(v6, v7, 0, 1, 2, 3, 4, 5, 6, 7), pb[1], o[1]);
    o[2] = MFMA32(__builtin_shufflevector(v10, v11, 0, 1, 2, 3, 4, 5, 6, 7), pb[1], o[2]);
    o[3] = MFMA32(__builtin_shufflevector(v14, v15, 0, 1, 2, 3, 4, 5, 6, 7), pb[1], o[3]);
    __builtin_amdgcn_s_setprio(0);
  }
  }
  __syncthreads();
  lrun += __shfl_xor(lrun, 32);
  const float inv = 1.f / lrun;
#pragma unroll
  for (int dt = 0; dt < 4; ++dt)
#pragma unroll
    for (int i = 0; i < 16; ++i) o[dt][i] *= inv;
  int rr = r;
  asm volatile("" : "+v"(rr));
  const u16* wv = reinterpret_cast<const u16*>(p.ws + OFF_WKVT) + (size_t)(w * 256 + 128) * 128;
  f32x16 at[4];
#pragma unroll
  for (int n2 = 0; n2 < 4; ++n2)
#pragma unroll
    for (int i = 0; i < 16; ++i) at[n2][i] = 0.f;
#pragma unroll
  for (int dt = 0; dt < 4; ++dt)
#pragma unroll
    for (int s2 = 0; s2 < 2; ++s2) {
      const bf16x8 pb = pack_step(o[dt], s2);
#pragma unroll
      for (int n2 = 0; n2 < 4; ++n2) {
        const u16* wp = wv + (size_t)(32 * n2 + rr) * 128 + 32 * dt + 16 * s2 + 4 * hf;
        s16x4 lo = *reinterpret_cast<const s16x4*>(wp);
        s16x4 hi = *reinterpret_cast<const s16x4*>(wp + 8);
        bf16x8 wa = __builtin_shufflevector(lo, hi, 0, 1, 2, 3, 4, 5, 6, 7);
        at[n2] = MFMA32(wa, pb, at[n2]);
      }
    }
  const u16* gbr = reinterpret_cast<const u16*>(p.ws + OFF_Z) + (size_t)(t0 + rr) * ZW + 1984 + w * 128;
  u16* mrow = reinterpret_cast<u16*>(p.ws + OFF_H) + (size_t)(t0 + rr) * 1024 + 512 + w * 128;
#pragma unroll
  for (int n2 = 0; n2 < 4; ++n2)
#pragma unroll
    for (int g4 = 0; g4 < 4; ++g4) {
      const int n = 32 * n2 + 8 * g4 + 4 * hf;
      const s16x4 gb = *reinterpret_cast<const s16x4*>(gbr + n);
      uint2 v;
      v.x = pack2(at[n2][4 * g4] * silu_f(bf2f((u16)gb[0])), at[n2][4 * g4 + 1] * silu_f(bf2f((u16)gb[1])));
      v.y = pack2(at[n2][4 * g4 + 2] * silu_f(bf2f((u16)gb[2])), at[n2][4 * g4 + 3] * silu_f(bf2f((u16)gb[3])));
      *reinterpret_cast<uint2*>(mrow + n) = v;
    }
}

DI void phase_attn(const Params& p, char* smem) {
  for (int u = blockIdx.x; u < 640; u += gridDim.x) attn_unit(p, u, smem);
}

DI void phase_attnout(const Params& p, char* smem) {
  const int tid = threadIdx.x, wid = tid >> 6, lane = tid & 63, wr = wid >> 1, wc = wid & 1, fr = lane & 15, fq = lane >> 4;
  const u16* Z = reinterpret_cast<const u16*>(p.ws + OFF_Z);
  u16* MIX = reinterpret_cast<u16*>(p.ws + OFF_H);
  for (int u = blockIdx.x; u < 640; u += gridDim.x) {
    const int mt = u >> 2, hh = u & 3;
    const u16* A = reinterpret_cast<const u16*>(p.ws + OFF_OLAT) + (size_t)mt * 128 * 512 + hh * 128;
    const u16* W = reinterpret_cast<const u16*>(p.ws + OFF_WKVT) + (size_t)(hh * 256 + 128) * 128;
    f32x4 acc[4][4];
    gemm_mainloop(A, 512, W, 128, 128, smem, acc);
#pragma unroll
    for (int m = 0; m < 4; ++m)
#pragma unroll
      for (int j = 0; j < 4; ++j) {
        const int t = mt * 128 + wr * 64 + m * 16 + fq * 4 + j;
#pragma unroll
        for (int n = 0; n < 4; ++n) {
          const int col = hh * 128 + wc * 64 + n * 16 + fr;
          float gb = silu_f(bf2f(Z[(size_t)t * ZW + 1984 + col]));
          MIX[(size_t)t * 1024 + 512 + col] = f2bf(acc[m][n][j] * gb);
        }
      }
  }
}

DI void phase_out(const Params& p, char* smem) {
  const int tid = threadIdx.x, wid = tid >> 6, lane = tid & 63, wr = wid >> 1, wc = wid & 1, fr = lane & 15, fq = lane >> 4;
  const u16* MIX = reinterpret_cast<const u16*>(p.ws + OFF_H);
  const u16* W = reinterpret_cast<const u16*>(p.ws + OFF_WOT);
  const float* mod = reinterpret_cast<const float*>(p.ws + OFF_MOD);
  float* SS = reinterpret_cast<float*>(p.ws + OFF_SS);
  u16* R = reinterpret_cast<u16*>(p.ws + OFF_Z);
  for (int u = blockIdx.x; u < 160 * 8; u += gridDim.x) {
    const int xcd = u & 7, iu = u >> 3;
    const int mt = (iu >> 3) * 8 + xcd, nt = iu & 7;
    f32x4 acc[4][4];
    gemm_mainloop(MIX + (size_t)mt * 128 * 1024, 1024, W + (size_t)nt * 128 * 1024, 1024, 1024, smem, acc);
    const float* gate = mod + cond_of(mt * 128) * 3072 + 2048 + nt * 128;
    const int col = (tid & 31) * 4;
    float4 xv[16];
#pragma unroll
    for (int i = 0; i < 16; ++i) xv[i] = *reinterpret_cast<const float4*>(xrow(p, mt * 128 + (tid >> 5) + i * 8) + nt * 128 + col);
    const float4 g4 = *reinterpret_cast<const float4*>(gate + col);
    float* stf = reinterpret_cast<float*>(smem);
#pragma unroll
    for (int m = 0; m < 4; ++m)
#pragma unroll
      for (int j = 0; j < 4; ++j) {
        const int row = wr * 64 + m * 16 + fq * 4 + j;
#pragma unroll
        for (int n = 0; n < 4; ++n) stf[row * 128 + ((wc * 64 + n * 16 + fr) ^ (fq * 16))] = acc[m][n][j];
      }
    __syncthreads();
#pragma unroll
    for (int i = 0; i < 16; ++i) {
      const int row = (tid >> 5) + i * 8, sw = ((row >> 2) & 3) * 16, t = mt * 128 + row;
      const float4 y = *reinterpret_cast<const float4*>(stf + row * 128 + (col ^ sw));
      float4 rv;
      rv.x = xv[i].x + g4.x * y.x; rv.y = xv[i].y + g4.y * y.y; rv.z = xv[i].z + g4.z * y.z; rv.w = xv[i].w + g4.w * y.w;
      *reinterpret_cast<uint2*>(R + (size_t)t * 1024 + nt * 128 + col) = make_uint2(pack2(rv.x, rv.y), pack2(rv.z, rv.w));
      float ss = rv.x * rv.x + rv.y * rv.y + rv.z * rv.z + rv.w * rv.w;
#pragma unroll
      for (int o = 16; o > 0; o >>= 1) ss += __shfl_xor(ss, o);
      if ((tid & 31) == 0) SS[(size_t)t * 16 + nt] = ss;
    }
    __syncthreads();
  }
}

DI void phase_final(const Params& p) {
  const int lane = threadIdx.x & 63, wid = threadIdx.x >> 6;
  const float* SS = reinterpret_cast<const float*>(p.ws + OFF_SS);
  const u16* R = reinterpret_cast<const u16*>(p.ws + OFF_Z);
  float4 g[4];
#pragma unroll
  for (int j = 0; j < 4; ++j) g[j] = *reinterpret_cast<const float4*>(p.final_g + j * 256 + lane * 4);
  for (int t = (blockIdx.x * 4 + wid) * 8; t < NTOK; t += gridDim.x * 32) {
    uint2 rb[8][4];
    float ssv[8];
#pragma unroll
    for (int k = 0; k < 8; ++k) {
      ssv[k] = (lane < 8) ? SS[(size_t)(t + k) * 16 + lane] : 0.f;
#pragma unroll
      for (int j = 0; j < 4; ++j) rb[k][j] = *reinterpret_cast<const uint2*>(R + (size_t)(t + k) * 1024 + j * 256 + lane * 4);
    }
#pragma unroll
    for (int k = 0; k < 8; ++k) {
      float ss = ssv[k];
#pragma unroll
      for (int o = 4; o > 0; o >>= 1) ss += __shfl_xor(ss, o);
      ss = __shfl(ss, 0);
      const float rstd = rsqrtf(ss * (1.f / 1024.f) + EPSF);
      float* row = p.out + (size_t)(t + k) * 1024;
#pragma unroll
      for (int j = 0; j < 4; ++j) {
        float4 v;
        v.x = bf2f((u16)(rb[k][j].x & 0xffff)) * rstd * g[j].x; v.y = bf2f((u16)(rb[k][j].x >> 16)) * rstd * g[j].y;
        v.z = bf2f((u16)(rb[k][j].y & 0xffff)) * rstd * g[j].z; v.w = bf2f((u16)(rb[k][j].y >> 16)) * rstd * g[j].w;
        *reinterpret_cast<float4*>(row + j * 256 + lane * 4) = v;
      }
    }
  }
}

#define XB_TMO      128
#define XB_XCNT(j)  (256  + 64 * (j))
#define XB_XSUB(j)  (1280 + 64 * (j))
#define XB_XGEN(j)  (2304 + 64 * (j))
#define XB_TOP      3328
#define XB_TOPGEN   3392
#define XB_SPIN_CAP (1u << 22)
DI unsigned xb_ld(unsigned* p) { return __hip_atomic_load(p, __ATOMIC_RELAXED, __HIP_MEMORY_SCOPE_AGENT); }
DI unsigned xb_add(unsigned* p, unsigned v) { return __hip_atomic_fetch_add(p, v, __ATOMIC_RELAXED, __HIP_MEMORY_SCOPE_AGENT); }
DI unsigned xb_xcc_id() { return (unsigned)__builtin_amdgcn_s_getreg((3 << 11) | 20) & 0xFu; }
#define XB_SPIN(cond, bar) do { unsigned _sp = 0; while (cond) { __builtin_amdgcn_s_sleep(1); \
    if ((++_sp & 255u) == 0u) { if (xb_ld(&(bar)[XB_TMO])) break; if (_sp > XB_SPIN_CAP) { atomicAdd(&(bar)[XB_TMO], 1u); break; } } } } while (0)
struct XcdBarrier { unsigned* bar; unsigned x, nloc, nx; };
DI void xcd_barrier_post(XcdBarrier& b, unsigned* bar) {
  b.bar = bar; b.x = xb_xcc_id(); b.nloc = 0u; b.nx = 0u;
  if (threadIdx.x == 0) (void)xb_add(&bar[XB_XCNT(b.x)], 1u);
}
DI void xcd_barrier_complete(unsigned* bar, unsigned x, unsigned& nloc, unsigned& nx) {
  const unsigned G = gridDim.x;
  unsigned sum, cnt, mine, sp = 0u;
  for (;;) {
    sum = 0u; cnt = 0u; mine = 0u;
#pragma unroll
    for (unsigned j = 0; j < 16; ++j) { const unsigned c = xb_ld(&bar[XB_XCNT(j)]); sum += c; cnt += (c > 0u) ? 1u : 0u; mine = (j == x) ? c : mine; }
    if (sum == G) break;
    __builtin_amdgcn_s_sleep(1);
    if ((++sp & 255u) == 0u) { if (xb_ld(&bar[XB_TMO])) break; if (sp > XB_SPIN_CAP) { atomicAdd(&bar[XB_TMO], 1u); break; } }
  }
  nloc = mine > 0u ? mine : 1u; nx = cnt > 0u ? cnt : 1u;
}
DI void xcd_barrier(XcdBarrier& b) {
  asm volatile("s_waitcnt vmcnt(0)" ::: "memory");
  __syncthreads();
  if (threadIdx.x == 0) {
    unsigned* bar = b.bar;
    __builtin_amdgcn_s_waitcnt(0);
    if (b.nloc == 0u) xcd_barrier_complete(bar, b.x, b.nloc, b.nx);
    const unsigned nloc = b.nloc, nx = b.nx;
    const unsigned old = xb_add(&bar[XB_XSUB(b.x)], 1u);
    const unsigned gen = old / nloc;
    if (old + 1u == (gen + 1u) * nloc) {
      __builtin_amdgcn_fence(__ATOMIC_RELEASE, "agent");
      asm volatile("s_waitcnt vmcnt(0)" ::: "memory");
      const unsigned og = xb_add(&bar[XB_TOP], 1u);
      const unsigned tg = og / nx;
      if (og + 1u == (tg + 1u) * nx) xb_add(&bar[XB_TOPGEN], 1u);
      else XB_SPIN(xb_ld(&bar[XB_TOPGEN]) == tg, bar);
      __builtin_amdgcn_fence(__ATOMIC_ACQUIRE, "agent");
      xb_add(&bar[XB_XGEN(b.x)], 1u);
      asm volatile("s_waitcnt vmcnt(0)" ::: "memory");
    } else {
      XB_SPIN(xb_ld(&bar[XB_XGEN(b.x)]) == gen, bar);
      __builtin_amdgcn_fence(__ATOMIC_ACQUIRE, "agent");
      asm volatile("s_waitcnt vmcnt(0)" ::: "memory");
    }
  }
  __syncthreads();
}

typedef const __attribute__((address_space(4))) Params* KargPtr;
DI Params load_params() {
#if defined(__HIP_DEVICE_COMPILE__)
  KargPtr pp = (KargPtr)__builtin_amdgcn_kernarg_segment_ptr();
  asm volatile("" : "+s"(pp));
  Params r;
  r.x_prompt = pp->x_prompt;
  r.x_sample = pp->x_sample;
  r.cache_ckv = pp->cache_ckv;
  r.cache_krope = pp->cache_krope;
  r.c = pp->c;
  r.c_ctx = pp->c_ctx;
  r.norm_g = pp->norm_g;
  r.w_ada = pp->w_ada;
  r.b_ada = pp->b_ada;
  r.w_in = pp->w_in;
  r.w_s = pp->w_s;
  r.b_s = pp->b_s;
  r.g_v = pp->g_v;
  r.q_norm_g = pp->q_norm_g;
  r.w_uq = pp->w_uq;
  r.kv_norm_g = pp->kv_norm_g;
  r.w_ukv = pp->w_ukv;
  r.w_o = pp->w_o;
  r.final_g = pp->final_g;
  r.out = pp->out;
  r.ws = pp->ws;
  return r;
#else
  return Params{};
#endif
}

template <int LO, int HI>
__global__ void __launch_bounds__(NT, 2) fwd_kernel(Params p_in) {
  __shared__ __attribute__((aligned(16))) char smem[65536];
  XcdBarrier xb;
  if constexpr (LO < HI) {
    const Params p = load_params();
    xcd_barrier_post(xb, reinterpret_cast<unsigned*>(p.ws + OFF_BAR));
    if (p.out == nullptr) cg::this_grid().sync();
  }
#ifndef REP_PHASE
#define REP_PHASE -1
#endif
#define PHASE(N, CALL) if constexpr (LO <= N && N <= HI) { { const Params p = load_params(); CALL; if constexpr (N == REP_PHASE && LO < HI) { CALL; } } if constexpr (N < HI) xcd_barrier(xb); }
  PHASE(0, phase_prep(p, smem))
  PHASE(1, phase_h(p))
  PHASE(2, phase_gemm1(p, smem))
  PHASE(3, phase_local(p, smem))
  PHASE(4, phase_attn(p, smem))
  PHASE(5, phase_out(p, smem))
  PHASE(6, phase_final(p))
}

template __global__ void fwd_kernel<2, 2>(Params);

extern "C" void kernel_launch(void* const* d_in, const int* in_sizes, int n_in, void* d_out, int out_size, void* d_ws,
                              size_t ws_size, hipStream_t stream) {
  Params p{};
  p.x_prompt = (const float*)d_in[0]; p.x_sample = (const float*)d_in[1]; p.cache_ckv = (const float*)d_in[2];
  p.cache_krope = (const float*)d_in[3]; p.c = (const float*)d_in[4]; p.c_ctx = (const float*)d_in[5];
  p.norm_g = (const float*)d_in[6]; p.w_ada = (const float*)d_in[7]; p.b_ada = (const float*)d_in[8];
  p.w_in = (const float*)d_in[9]; p.w_s = (const float*)d_in[10]; p.b_s = (const float*)d_in[11];
  p.g_v = (const float*)d_in[12]; p.q_norm_g = (const float*)d_in[13]; p.w_uq = (const float*)d_in[14];
  p.kv_norm_g = (const float*)d_in[15]; p.w_ukv = (const float*)d_in[16]; p.w_o = (const float*)d_in[17];
  p.final_g = (const float*)d_in[18];
  p.out = (float*)d_out;
  p.ws = (char*)d_ws;
  if (ws_size < WS_TOTAL) { fprintf(stderr, "workspace too small: %zu < %zu\n", ws_size, WS_TOTAL); return; }
#if 0
  hipLaunchKernelGGL((fwd_kernel<0, 0>), dim3(512), dim3(NT), 0, stream, p);
  hipLaunchKernelGGL((fwd_kernel<1, 1>), dim3(512), dim3(NT), 0, stream, p);
  hipLaunchKernelGGL((fwd_kernel<2, 2>), dim3(512), dim3(NT), 0, stream, p);
  hipLaunchKernelGGL((fwd_kernel<3, 3>), dim3(512), dim3(NT), 0, stream, p);
  hipLaunchKernelGGL((fwd_kernel<4, 4>), dim3(512), dim3(NT), 0, stream, p);
  hipLaunchKernelGGL((fwd_kernel<5, 5>), dim3(512), dim3(NT), 0, stream, p);
  hipLaunchKernelGGL((fwd_kernel<6, 6>), dim3(512), dim3(NT), 0, stream, p);
  hipLaunchKernelGGL((fwd_kernel<7, 7>), dim3(512), dim3(NT), 0, stream, p);
#else
  static int grid_blocks = 0;
  if (!grid_blocks) {
    int dev = 0, cus = 0, per_cu = 0;
    hipGetDevice(&dev);
    hipDeviceGetAttribute(&cus, hipDeviceAttributeMultiprocessorCount, dev);
    hipOccupancyMaxActiveBlocksPerMultiprocessor(&per_cu, fwd_kernel<0, 6>, NT, 0);
    if (per_cu > 2) per_cu = 2;
    grid_blocks = cus * per_cu;
  }
  hipMemsetAsync((char*)d_ws + OFF_BAR, 0, (3456 + 256) * 4, stream);
  void* args[] = {&p};
  hipError_t e = hipLaunchCooperativeKernel((void*)fwd_kernel<0, 6>, dim3(grid_blocks), dim3(NT), args, 0, stream);
  if (e != hipSuccess) fprintf(stderr, "cooperative launch failed: %s (grid %d)\n", hipGetErrorString(e), grid_blocks);
#endif
}
```

```cpp
#include <hip/hip_runtime.h>
#include <hip/hip_cooperative_groups.h>
#include <cstdio>
namespace cg = cooperative_groups;

typedef unsigned short u16;
using bf16x8 = __attribute__((ext_vector_type(8))) short;
using s16x4  = __attribute__((ext_vector_type(4))) short;
using f32x4  = __attribute__((ext_vector_type(4))) float;
using f32x16 = __attribute__((ext_vector_type(16))) float;
using u32x4  = __attribute__((ext_vector_type(4))) unsigned;
#define DI __device__ __forceinline__

constexpr int NT = 256;
constexpr int NTOK = 20480;
constexpr int NCTX = 4096;
constexpr int DM = 1024;
constexpr int ZW = 2560;
constexpr int INW = 2496;
constexpr float EPSF = 1e-6f;
constexpr float QSCALE = 0.07216878364870322f * 1.4426950408889634f;

constexpr size_t OFF_MOD   = 0;
constexpr size_t OFF_WINT  = OFF_MOD   + 9 * 3072 * 4;
constexpr size_t OFF_WOT   = OFF_WINT  + (size_t)ZW * 1024 * 2;
constexpr size_t OFF_WQT   = OFF_WOT   + (size_t)1024 * 1024 * 2;
constexpr size_t OFF_WKVT  = OFF_WQT   + (size_t)768 * 256 * 2;
constexpr size_t OFF_WSB   = OFF_WKVT  + (size_t)1024 * 128 * 2;
constexpr size_t OFF_ROPE  = OFF_WSB   + (size_t)4 * 128 * 128 * 2;
constexpr size_t OFF_H     = OFF_ROPE  + (size_t)2048 * 32 * 2 * 4;
constexpr size_t OFF_Z     = OFF_H     + (size_t)NTOK * 1024 * 2;
constexpr size_t OFF_Q     = OFF_Z     + (size_t)NTOK * ZW * 2;
constexpr size_t OFF_KC    = OFF_Q     + (size_t)NTOK * 768 * 2;
constexpr size_t OFF_VTC   = OFF_KC    + (size_t)16 * 256 * 192 * 2;
constexpr size_t OFF_KS    = OFF_VTC   + (size_t)16 * 128 * 256 * 2;
constexpr size_t OFF_VTS   = OFF_KS    + (size_t)8 * 2560 * 192 * 2;
constexpr size_t OFF_OLAT  = OFF_VTS   + (size_t)8 * 128 * 2560 * 2;
constexpr size_t OFF_SS    = OFF_OLAT  + (size_t)NTOK * 512 * 2;
constexpr size_t OFF_BAR   = OFF_SS    + (size_t)NTOK * 16 * 4;
constexpr size_t OFF_CNT   = OFF_BAR   + 3456 * 4;
constexpr size_t WS_TOTAL  = OFF_CNT   + 256 * 4;

struct Params {
  const float *x_prompt, *x_sample, *cache_ckv, *cache_krope, *c, *c_ctx, *norm_g, *w_ada, *b_ada, *w_in, *w_s, *b_s,
      *g_v, *q_norm_g, *w_uq, *kv_norm_g, *w_ukv, *w_o, *final_g;
  float* out;
  char* ws;
};

typedef float f32x2_t __attribute__((ext_vector_type(2)));
DI float max3f(float a, float b, float c) { float r; asm("v_max3_f32 %0, %1, %2, %3" : "=v"(r) : "v"(a), "v"(b), "v"(c)); return r; }
DI float max3f_after_mfma(float a, float b, float c) { float r; asm volatile("s_nop 11\n\tv_max3_f32 %0, %1, %2, %3" : "=v"(r) : "v"(a), "v"(b), "v"(c)); return r; }
DI int opaque_tid() { int t = threadIdx.x; asm volatile("" : "+v"(t)); return t; }
typedef __bf16 bf16x2_t __attribute__((ext_vector_type(2)));
typedef float f32x2c_t __attribute__((ext_vector_type(2)));
DI unsigned pack2(float a, float b) { f32x2c_t v = {a, b}; return __builtin_bit_cast(unsigned, __builtin_convertvector(v, bf16x2_t)); }
DI u16 f2bf(float x) { return (u16)(pack2(x, 0.f) & 0xffffu); }
DI float bf2f(u16 v) { return __uint_as_float(((unsigned)v) << 16); }
DI float gelu_f(float x) { float u = 0.7978845608028654f * (x + 0.044715f * x * x * x); return x * __builtin_amdgcn_rcpf(1.f + __expf(-2.f * u)); }
DI float silu_f(float x) { return x * __builtin_amdgcn_rcpf(1.f + __expf(-x)); }
DI const float* xrow(const Params& p, int t) { return t < NCTX ? p.x_prompt + (size_t)t * DM : p.x_sample + (size_t)(t - NCTX) * DM; }
DI int cond_of(int t) { return t < NCTX ? 8 : ((t - NCTX) >> 11); }

#define MFMA16(a, b, c) __builtin_amdgcn_mfma_f32_16x16x32_bf16((a), (b), (c), 0, 0, 0)
#define MFMA32(a, b, c) __builtin_amdgcn_mfma_f32_32x32x16_bf16((a), (b), (c), 0, 0, 0)

DI int lds_byte(int r, int c) {
  int st = (r >> 4) * 2 + (c >> 5), rr = r & 15, cc = c & 31, ob = rr * 64 + cc * 2;
  return st * 1024 + (ob ^ (((ob >> 9) & 1) << 5));
}
DI void stage_rc(int b, int& R, int& C) {
  int st = b >> 10, sb = b & 1023, swz = sb ^ (((sb >> 9) & 1) << 5);
  R = (st >> 1) * 16 + (swz >> 6); C = (st & 1) * 32 + ((swz & 63) >> 1);
}

DI void gemm_stage(const u16* A, int lda, const u16* Bt, int ldb, int kt, char* buf, int tid) {
#pragma unroll
  for (int i = 0; i < 4; ++i) {
    int b = tid * 16 + i * 4096, r, c; stage_rc(b, r, c);
    __builtin_amdgcn_global_load_lds((const unsigned*)(A + (size_t)r * lda + kt * 64 + c), (unsigned*)(buf + b), 16, 0, 0);
    __builtin_amdgcn_global_load_lds((const unsigned*)(Bt + (size_t)r * ldb + kt * 64 + c), (unsigned*)(buf + 16384 + b), 16, 0, 0);
  }
}

DI void gemm_mainloop(const u16* A, int lda, const u16* Bt, int ldb, int K, char* smem, f32x4 (&acc)[4][4], bool staged0 = false, int tid_in = -1) {
  const int tid = tid_in < 0 ? (int)threadIdx.x : tid_in, wid = tid >> 6, lane = tid & 63, wr = wid >> 1, wc = wid & 1, fr = lane & 15, fq = lane >> 4;
#pragma unroll
  for (int m = 0; m < 4; ++m)
#pragma unroll
    for (int n = 0; n < 4; ++n) acc[m][n] = f32x4{0.f, 0.f, 0.f, 0.f};
  const int nt = K >> 6;
  if (!staged0) gemm_stage(A, lda, Bt, ldb, 0, smem, tid);
  for (int t = 0; t < nt; ++t) {
    asm volatile("s_waitcnt vmcnt(0)" ::: "memory");
    __syncthreads();
    if (t + 1 < nt) gemm_stage(A, lda, Bt, ldb, t + 1, smem + ((t + 1) & 1) * 32768, tid);
    const char* sa = smem + (t & 1) * 32768;
    const char* sb = sa + 16384;
#pragma unroll
    for (int k = 0; k < 2; ++k) {
      bf16x8 af[4], bfr[4];
#pragma unroll
      for (int m = 0; m < 4; ++m) af[m] = *reinterpret_cast<const bf16x8*>(sa + lds_byte(wr * 64 + m * 16 + fr, k * 32 + fq * 8));
#pragma unroll
      for (int n = 0; n < 4; ++n) bfr[n] = *reinterpret_cast<const bf16x8*>(sb + lds_byte(wc * 64 + n * 16 + fr, k * 32 + fq * 8));
#pragma unroll
      for (int m = 0; m < 4; ++m)
#pragma unroll
        for (int n = 0; n < 4; ++n) acc[m][n] = MFMA16(af[m], bfr[n], acc[m][n]);
    }
  }
  __syncthreads();
}

DI void store_tile_bf16(f32x4 (&acc)[4][4], char* smem, u16* dst, int ldc, const float* rowscale, int tid_in = -1) {
  const int tid = tid_in < 0 ? (int)threadIdx.x : tid_in, wid = tid >> 6, lane = tid & 63, wr = wid >> 1, wc = wid & 1, fr = lane & 15, fq = lane >> 4;
  u16* st = reinterpret_cast<u16*>(smem);
#pragma unroll
  for (int m = 0; m < 4; ++m)
#pragma unroll
    for (int j = 0; j < 4; ++j) {
      int row = wr * 64 + m * 16 + fq * 4 + j;
      float rs = rowscale ? rowscale[row] : 1.f;
#pragma unroll
      for (int n = 0; n < 4; ++n) st[row * 136 + wc * 64 + n * 16 + fr] = f2bf(acc[m][n][j] * rs);
    }
  __syncthreads();
#pragma unroll
  for (int i = 0; i < 8; ++i) {
    int c = tid + i * 256, row = c >> 4, off = c & 15;
    *reinterpret_cast<uint4*>(dst + (size_t)row * ldc + off * 8) = *reinterpret_cast<const uint4*>(smem + row * 272 + off * 16);
  }
  __syncthreads();
}

DI void prep_mod(const Params& p, int unit, float* sm) {
  const int tid = threadIdx.x;
  for (int e = tid; e < 9 * 1024; e += NT) {
    int i = e >> 10, k = e & 1023;
    float v = (i < 8) ? p.c[i * 1024 + k] : p.c_ctx[k];
    sm[e] = silu_f(v);
  }
  __syncthreads();
  const int c4 = tid & 7, kg = tid >> 3, n0 = unit * 32 + c4 * 4;
  float acc[9][4];
#pragma unroll
  for (int i = 0; i < 9; ++i) { acc[i][0] = acc[i][1] = acc[i][2] = acc[i][3] = 0.f; }
#pragma unroll 4
  for (int j = 0; j < 32; ++j) {
    int k = j * 32 + kg;
    float4 w = *reinterpret_cast<const float4*>(p.w_ada + (size_t)k * 3072 + n0);
#pragma unroll
    for (int i = 0; i < 9; ++i) {
      float s = sm[i * 1024 + k];
      acc[i][0] += s * w.x; acc[i][1] += s * w.y; acc[i][2] += s * w.z; acc[i][3] += s * w.w;
    }
  }
  __syncthreads();
#pragma unroll
  for (int i = 0; i < 9; ++i)
#pragma unroll
    for (int e = 0; e < 4; ++e) sm[(kg * 36 + i * 4 + e) * 8 + c4] = acc[i][e];
  __syncthreads();
  float* mod = reinterpret_cast<float*>(p.ws + OFF_MOD);
  for (int o = tid; o < 288; o += NT) {
    int ie = o >> 3, cc = o & 7;
    float s = 0.f;
    for (int g = 0; g < 32; ++g) s += sm[(g * 36 + ie) * 8 + cc];
    int i = ie >> 2, e = ie & 3, n = unit * 32 + cc * 4 + e;
    mod[i * 3072 + n] = s + p.b_ada[n];
  }
  __syncthreads();
}

DI void transpose_unit(const float* src, int ldsrc, int ncols_valid, u16* dst, int lddst, int k0, int n0, float* sm) {
  const int tid = threadIdx.x;
  float4 v[8];
#pragma unroll
  for (int i = 0; i < 8; ++i) {
    const int e = tid + i * NT, kk = e >> 5, c4 = e & 31, n = n0 + c4 * 4;
    v[i] = (n < ncols_valid) ? *reinterpret_cast<const float4*>(src + (size_t)(k0 + kk) * ldsrc + n) : make_float4(0.f, 0.f, 0.f, 0.f);
  }
#pragma unroll
  for (int i = 0; i < 8; ++i) {
    const int e = tid + i * NT, kk = e >> 5, c4 = e & 31;
    float* d = sm + kk * 129 + c4 * 4;
    d[0] = v[i].x; d[1] = v[i].y; d[2] = v[i].z; d[3] = v[i].w;
  }
  __syncthreads();
  const int nn = tid >> 1, seg = tid & 1;
  unsigned w[16];
#pragma unroll
  for (int i = 0; i < 16; ++i) w[i] = pack2(sm[(seg * 32 + 2 * i) * 129 + nn], sm[(seg * 32 + 2 * i + 1) * 129 + nn]);
  uint4* o = reinterpret_cast<uint4*>(dst + (size_t)(n0 + nn) * lddst + k0 + seg * 32);
#pragma unroll
  for (int i = 0; i < 4; ++i) o[i] = make_uint4(w[4 * i], w[4 * i + 1], w[4 * i + 2], w[4 * i + 3]);
  __syncthreads();
}

DI void prep_wq(const Params& p, int unit) {
  const int c = threadIdx.x, h = unit / 192, r = unit % 192;
  const float g = p.q_norm_g[c] * QSCALE;
  float v;
  if (r < 128) {
    const float4* a = reinterpret_cast<const float4*>(p.w_uq + (size_t)c * 768 + h * 192);
    const float4* b = reinterpret_cast<const float4*>(p.w_ukv + (size_t)r * 1024 + h * 256);
    float s = 0.f;
#pragma unroll 8
    for (int j = 0; j < 32; ++j) { float4 x = a[j], y = b[j]; s += x.x * y.x + x.y * y.y + x.z * y.z + x.w * y.w; }
    v = s;
  } else {
    v = p.w_uq[(size_t)c * 768 + h * 192 + r];
  }
  reinterpret_cast<u16*>(p.ws + OFF_WQT)[unit * 256 + c] = f2bf(v * g);
}

DI void prep_cache(const Params& p, int unit, float* sm) {
  const int tid = threadIdx.x, b = unit >> 3, j0 = (unit & 7) * 64;
  u16* Ks = reinterpret_cast<u16*>(p.ws + OFF_KS) + (size_t)b * 2560 * 192;
  u16* VT = reinterpret_cast<u16*>(p.ws + OFF_VTS) + (size_t)b * 128 * 2560;
  const float* ck = p.cache_ckv + ((size_t)b * 512 + j0) * 128;
  const float* kr = p.cache_krope + ((size_t)b * 512 + j0) * 64;
  for (int e = tid; e < 64 * 32; e += NT) {
    int j = e >> 5, c4 = e & 31;
    float4 v = *reinterpret_cast<const float4*>(ck + (size_t)j * 128 + c4 * 4);
    float* d = sm + j * 129 + c4 * 4;
    d[0] = v.x; d[1] = v.y; d[2] = v.z; d[3] = v.w;
    uint2 o; o.x = pack2(v.x, v.y); o.y = pack2(v.z, v.w);
    *reinterpret_cast<uint2*>(Ks + (size_t)(2048 + j0 + j) * 192 + c4 * 4) = o;
  }
  for (int e = tid; e < 64 * 16; e += NT) {
    int j = e >> 4, c4 = e & 15;
    float4 v = *reinterpret_cast<const float4*>(kr + (size_t)j * 64 + c4 * 4);
    uint2 o; o.x = pack2(v.x, v.y); o.y = pack2(v.z, v.w);
    *reinterpret_cast<uint2*>(Ks + (size_t)(2048 + j0 + j) * 192 + 128 + c4 * 4) = o;
  }
  __syncthreads();
  const int r = tid >> 1, half = tid & 1;
  unsigned w[16];
#pragma unroll
  for (int i = 0; i < 16; ++i) w[i] = pack2(sm[(half * 32 + 2 * i) * 129 + r], sm[(half * 32 + 2 * i + 1) * 129 + r]);
  uint4* o = reinterpret_cast<uint4*>(VT + (size_t)r * 2560 + 2048 + j0 + half * 32);
#pragma unroll
  for (int i = 0; i < 4; ++i) o[i] = make_uint4(w[4 * i], w[4 * i + 1], w[4 * i + 2], w[4 * i + 3]);
  __syncthreads();
}

DI void phase_prep(const Params& p, char* smem) {
  float* sm = reinterpret_cast<float*>(smem);
  const int tid = threadIdx.x;
  for (int u = blockIdx.x; u < 1424; u += gridDim.x) {
    int v = u;
    if (v < 96) { prep_mod(p, v, sm); continue; }
    v -= 96;
    if (v < 320) { transpose_unit(p.w_in, INW, INW, reinterpret_cast<u16*>(p.ws + OFF_WINT), 1024, (v & 15) * 64, (v >> 4) * 128, sm); continue; }
    v -= 320;
    if (v < 128) { transpose_unit(p.w_o, 1024, 1024, reinterpret_cast<u16*>(p.ws + OFF_WOT), 1024, (v & 15) * 64, (v >> 4) * 128, sm); continue; }
    v -= 128;
    if (v < 768) { prep_wq(p, v); continue; }
    v -= 768;
    if (v < 16) { transpose_unit(p.w_ukv, 1024, 1024, reinterpret_cast<u16*>(p.ws + OFF_WKVT), 128, (v & 1) * 64, (v >> 1) * 128, sm); continue; }
    v -= 16;
    if (v < 16) {
      u16* d = reinterpret_cast<u16*>(p.ws + OFF_WSB);
      for (int e = v * 4096 + tid; e < (v + 1) * 4096; e += NT) d[e] = f2bf(p.w_s[e]);
      continue;
    }
    v -= 16;
    if (v < 64) { prep_cache(p, v, sm); continue; }
    v -= 64;
    {
      float* tc = reinterpret_cast<float*>(p.ws + OFF_ROPE);
      float* ts = tc + 2048 * 32;
      for (int e = v * 4096 + tid; e < (v + 1) * 4096; e += NT) {
        int pos = e >> 5, i = e & 31;
        float inv = powf(10000.f, -(float)(i & 15) / 16.f);
        float a = (float)((i < 16) ? (pos >> 6) : (pos & 63)) * inv;
        tc[e] = cosf(a); ts[e] = sinf(a);
      }
    }
  }
}

DI void phase_h(const Params& p) {
  const int lane = threadIdx.x & 63, wid = threadIdx.x >> 6;
  const float* mod = reinterpret_cast<const float*>(p.ws + OFF_MOD);
  u16* H = reinterpret_cast<u16*>(p.ws + OFF_H);
  for (int t = (blockIdx.x * 4 + wid) * 2; t < NTOK; t += gridDim.x * 8) {
    float4 v[2][4];
#pragma unroll
    for (int k = 0; k < 2; ++k) {
      const float* x = xrow(p, t + k);
#pragma unroll
      for (int j = 0; j < 4; ++j) v[k][j] = *reinterpret_cast<const float4*>(x + j * 256 + lane * 4);
    }
    const float* md = mod + cond_of(t) * 3072;
    float4 g[4], sh[4], sc[4];
#pragma unroll
    for (int j = 0; j < 4; ++j) {
      const int c = j * 256 + lane * 4;
      g[j] = *reinterpret_cast<const float4*>(p.norm_g + c);
      sh[j] = *reinterpret_cast<const float4*>(md + c);
      sc[j] = *reinterpret_cast<const float4*>(md + 1024 + c);
    }
#pragma unroll
    for (int k = 0; k < 2; ++k) {
      float ss = 0.f;
#pragma unroll
      for (int j = 0; j < 4; ++j) ss += v[k][j].x * v[k][j].x + v[k][j].y * v[k][j].y + v[k][j].z * v[k][j].z + v[k][j].w * v[k][j].w;
#pragma unroll
      for (int o = 32; o > 0; o >>= 1) ss += __shfl_xor(ss, o);
      const float rstd = rsqrtf(ss * (1.f / 1024.f) + EPSF);
#pragma unroll
      for (int j = 0; j < 4; ++j) {
        const int c = j * 256 + lane * 4;
        float a0 = v[k][j].x * rstd * g[j].x * (1.f + sc[j].x) + sh[j].x;
        float a1 = v[k][j].y * rstd * g[j].y * (1.f + sc[j].y) + sh[j].y;
        float a2 = v[k][j].z * rstd * g[j].z * (1.f + sc[j].z) + sh[j].z;
        float a3 = v[k][j].w * rstd * g[j].w * (1.f + sc[j].w) + sh[j].w;
        uint2 o; o.x = pack2(a0, a1); o.y = pack2(a2, a3);
        *reinterpret_cast<uint2*>(H + (size_t)(t + k) * 1024 + c) = o;
      }
    }
  }
}

DI void phase_gemm1(const Params& p, char* smem) {
  const u16* H = reinterpret_cast<const u16*>(p.ws + OFF_H);
  const u16* W = reinterpret_cast<const u16*>(p.ws + OFF_WINT);
  u16* Z = reinterpret_cast<u16*>(p.ws + OFF_Z);
  for (int u = blockIdx.x; u < 160 * 20; u += gridDim.x) {
    const int xcd = u & 7, iu = u >> 3;
    int mt = (iu / 20) * 8 + xcd, nt = iu % 20;
    f32x4 acc[4][4];
    gemm_mainloop(H + (size_t)mt * 128 * 1024, 1024, W + (size_t)nt * 128 * 1024, 1024, 1024, smem, acc);
    store_tile_bf16(acc, smem, Z + (size_t)mt * 128 * ZW + nt * 128, ZW, nullptr);
  }
}

DI void chunk_mlp_unit(const Params& p, int unit, char* smem) {
  const int tid = opaque_tid(), wid = tid >> 6, lane = tid & 63, fr = lane & 15, fq = lane >> 4;
  const int ck = unit >> 2, hh = unit & 3, t0 = ck * 128;
  const u16* Z = reinterpret_cast<const u16*>(p.ws + OFF_Z);
  u16* MIX = reinterpret_cast<u16*>(p.ws + OFF_H);
  u16* vnT = reinterpret_cast<u16*>(smem);
  {
    const int q = tid >> 1, half = tid & 1;
    const u16* src = Z + (size_t)(t0 + q) * ZW + 512 + hh * 128 + half * 64;
    float g[64];
    float ss = 0.f;
#pragma unroll
    for (int i = 0; i < 8; ++i) {
      bf16x8 v = *reinterpret_cast<const bf16x8*>(src + i * 8);
#pragma unroll
      for (int j = 0; j < 8; ++j) { float x = gelu_f(bf2f((u16)v[j])); g[i * 8 + j] = x; ss += x * x; }
    }
    ss += __shfl_xor(ss, 1);
    const float rstd = rsqrtf(ss * (1.f / 128.f) + EPSF);
    const float* gv = p.g_v + hh * 128 + half * 64;
#pragma unroll
    for (int i = 0; i < 64; ++i) vnT[(half * 64 + i) * 136 + q] = f2bf(g[i] * rstd * gv[i]);
  }
  __syncthreads();
  const u16* wsb = reinterpret_cast<const u16*>(p.ws + OFF_WSB) + hh * 16384;
  f32x4 acc[2][8];
#pragma unroll
  for (int m = 0; m < 2; ++m)
#pragma unroll
    for (int n = 0; n < 8; ++n) acc[m][n] = f32x4{0.f, 0.f, 0.f, 0.f};
#pragma unroll
  for (int ks = 0; ks < 4; ++ks) {
    bf16x8 a[2];
#pragma unroll
    for (int m = 0; m < 2; ++m) a[m] = *reinterpret_cast<const bf16x8*>(wsb + (wid * 32 + m * 16 + fr) * 128 + ks * 32 + fq * 8);
#pragma unroll
    for (int n = 0; n < 8; ++n) {
      bf16x8 b = *reinterpret_cast<const bf16x8*>(vnT + (n * 16 + fr) * 136 + ks * 32 + fq * 8);
#pragma unroll
      for (int m = 0; m < 2; ++m) acc[m][n] = MFMA16(a[m], b, acc[m][n]);
    }
  }
  bf16x8 uu[8], gg[8];
#pragma unroll
  for (int i = 0; i < 8; ++i) {
    const int c = tid + i * 256, row = c >> 4, col = (c & 15) * 8;
    const u16* zr = Z + (size_t)(t0 + row) * ZW + hh * 128 + col;
    uu[i] = *reinterpret_cast<const bf16x8*>(zr);
    gg[i] = *reinterpret_cast<const bf16x8*>(zr + 1024);
  }
  __syncthreads();
  float* stf = reinterpret_cast<float*>(smem);
#pragma unroll
  for (int m = 0; m < 2; ++m)
#pragma unroll
    for (int j = 0; j < 4; ++j) {
      const int pr = wid * 32 + m * 16 + fq * 4 + j;
      const float bs = p.b_s[hh * 128 + pr];
#pragma unroll
      for (int n = 0; n < 8; ++n) stf[pr * 128 + ((n * 16 + fr) ^ (fq * 16))] = acc[m][n][j] + bs;
    }
  __syncthreads();
#pragma unroll
  for (int i = 0; i < 8; ++i) {
    const int c = tid + i * 256, row = c >> 4, col = (c & 15) * 8, sw = ((row >> 2) & 3) * 16;
    const float4 m0 = *reinterpret_cast<const float4*>(stf + row * 128 + (col ^ sw));
    const float4 m1 = *reinterpret_cast<const float4*>(stf + row * 128 + ((col + 4) ^ sw));
    const float mm[8] = {m0.x, m0.y, m0.z, m0.w, m1.x, m1.y, m1.z, m1.w};
    float o8[8];
#pragma unroll
    for (int k = 0; k < 8; ++k) o8[k] = gelu_f(bf2f((u16)uu[i][k])) * mm[k] * silu_f(bf2f((u16)gg[i][k]));
    uint4 ov = make_uint4(pack2(o8[0], o8[1]), pack2(o8[2], o8[3]), pack2(o8[4], o8[5]), pack2(o8[6], o8[7]));
    *reinterpret_cast<uint4*>(MIX + (size_t)(t0 + row) * 1024 + hh * 128 + col) = ov;
  }
  __syncthreads();
}

DI void qproj_unit(const Params& p, int unit, char* smem) {
  const int tid = opaque_tid();
  const int mt = unit / 3, np = unit % 3;
  const u16* A = reinterpret_cast<const u16*>(p.ws + OFF_Z) + (size_t)mt * 128 * ZW + 1536;
  const u16* W = reinterpret_cast<const u16*>(p.ws + OFF_WQT) + (size_t)np * 256 * 256;
  float* rs = reinterpret_cast<float*>(smem + 65536 - 512);
  gemm_stage(A, ZW, W, 256, 0, smem, tid);
  float myrs;
  {
    const int row = tid >> 1, half = tid & 1;
    const u16* src = A + (size_t)row * ZW + half * 128;
    float ss = 0.f;
#pragma unroll
    for (int i = 0; i < 16; ++i) {
      bf16x8 v = *reinterpret_cast<const bf16x8*>(src + i * 8);
#pragma unroll
      for (int j = 0; j < 8; ++j) { float x = bf2f((u16)v[j]); ss += x * x; }
    }
    ss += __shfl_xor(ss, 1);
    myrs = rsqrtf(ss * (1.f / 256.f) + EPSF);
  }
#pragma unroll 1
  for (int h2 = 0; h2 < 2; ++h2) {
    f32x4 acc[4][4];
    gemm_mainloop(A, ZW, W + (size_t)h2 * 128 * 256, 256, 256, smem, acc, h2 == 0, tid);
    if ((tid & 1) == 0) rs[tid >> 1] = myrs;
    __syncthreads();
    store_tile_bf16(acc, smem, reinterpret_cast<u16*>(p.ws + OFF_Q) + (size_t)mt * 128 * 768 + (np * 2 + h2) * 128, 768, rs, tid);
  }
}

DI void kv_unit(const Params& p, int unit, char* smem) {
  const int tid = opaque_tid(), lane = tid & 63, wid = tid >> 6;
  const u16* Z = reinterpret_cast<const u16*>(p.ws + OFF_Z);
  const float* tc = reinterpret_cast<const float*>(p.ws + OFF_ROPE);
  const float* ts = tc + 2048 * 32;
  const float g0 = p.kv_norm_g[lane * 2], g1 = p.kv_norm_g[lane * 2 + 1];
  u16* tile = reinterpret_cast<u16*>(smem);
  const int t0 = unit * 64;
  const bool ctx = t0 < NCTX;
  const int b = ctx ? (t0 >> 8) : ((t0 - NCTX) >> 11), pos0 = ctx ? (t0 & 255) : ((t0 - NCTX) & 2047);
  const int ldv = ctx ? 256 : 2560;
  u16* Kb = ctx ? reinterpret_cast<u16*>(p.ws + OFF_KC) + (size_t)b * 256 * 192 : reinterpret_cast<u16*>(p.ws + OFF_KS) + (size_t)b * 2560 * 192;
  u16* VTb = ctx ? reinterpret_cast<u16*>(p.ws + OFF_VTC) + (size_t)b * 128 * 256 : reinterpret_cast<u16*>(p.ws + OFF_VTS) + (size_t)b * 128 * 2560;
  unsigned cvv[16]; u16 krv[16]; float csv[16], snv[16];
#pragma unroll
  for (int i = 0; i < 16; ++i) {
    const int tl = wid * 16 + i;
    const u16* zr = Z + (size_t)(t0 + tl) * ZW;
    cvv[i] = *reinterpret_cast<const unsigned*>(zr + 1792 + lane * 2);
    krv[i] = zr[1920 + lane];
    csv[i] = ctx ? 1.f : tc[(pos0 + tl) * 32 + (lane & 31)];
    snv[i] = ctx ? 0.f : ts[(pos0 + tl) * 32 + (lane & 31)];
  }
#pragma unroll
  for (int i = 0; i < 16; ++i) {
    const int tl = wid * 16 + i, t = t0 + tl, pos = pos0 + tl;
    float a0 = bf2f((u16)(cvv[i] & 0xffff)), a1 = bf2f((u16)(cvv[i] >> 16));
    float ss = a0 * a0 + a1 * a1;
#pragma unroll
    for (int o = 32; o > 0; o >>= 1) ss += __shfl_xor(ss, o);
    const float rstd = rsqrtf(ss * (1.f / 128.f) + EPSF);
    a0 *= rstd * g0; a1 *= rstd * g1;
    float kr = bf2f(krv[i]);
    if (ctx) {
      float* o_ckv = p.out + (size_t)NTOK * 1024 + (size_t)t * 128;
      float* o_kr = p.out + (size_t)NTOK * 1024 + (size_t)NCTX * 128 + (size_t)t * 64;
      *reinterpret_cast<float2*>(o_ckv + lane * 2) = make_float2(a0, a1);
      o_kr[lane] = kr;
    } else {
      float other = __shfl_xor(kr, 32);
      kr = (lane < 32) ? (kr * csv[i] - other * snv[i]) : (other * snv[i] + kr * csv[i]);
    }
    u16* Kd = Kb + (size_t)pos * 192;
    const unsigned pk = pack2(a0, a1);
    *reinterpret_cast<unsigned*>(Kd + lane * 2) = pk;
    Kd[128 + lane] = f2bf(kr);
    *reinterpret_cast<unsigned*>(tile + tl * 136 + lane * 2) = pk;
  }
  __syncthreads();
  {
    const int r = tid >> 1, half = tid & 1;
    unsigned w[16];
#pragma unroll
    for (int k = 0; k < 16; ++k)
      w[k] = (unsigned)tile[(half * 32 + 2 * k) * 136 + r] | ((unsigned)tile[(half * 32 + 2 * k + 1) * 136 + r] << 16);
    uint4* o = reinterpret_cast<uint4*>(VTb + (size_t)r * ldv + pos0 + half * 32);
#pragma unroll
    for (int k = 0; k < 4; ++k) o[k] = make_uint4(w[4 * k], w[4 * k + 1], w[4 * k + 2], w[4 * k + 3]);
  }
  __syncthreads();
}

DI void phase_local(const Params& p, char* smem) {
  for (int u = blockIdx.x; u < 1440; u += gridDim.x) {
    if (u < 640) chunk_mlp_unit(p, u, smem);
    else if (u < 1120) qproj_unit(p, u - 640, smem);
    else kv_unit(p, u - 1120, smem);
  }
}

DI bf16x8 pack_step(const f32x16& x, int s) {
  u32x4 r;
  asm volatile("v_cvt_pk_bf16_f32 %0, %4, %5\n\tv_cvt_pk_bf16_f32 %1, %6, %7\n\tv_cvt_pk_bf16_f32 %2, %8, %9\n\tv_cvt_pk_bf16_f32 %3, %10, %11\n\ts_nop 1"
               : "=&v"(r[0]), "=&v"(r[1]), "=&v"(r[2]), "=&v"(r[3])
               : "v"(x[8 * s]), "v"(x[8 * s + 1]), "v"(x[8 * s + 2]), "v"(x[8 * s + 3]), "v"(x[8 * s + 4]), "v"(x[8 * s + 5]), "v"(x[8 * s + 6]), "v"(x[8 * s + 7]));
  return __builtin_bit_cast(bf16x8, r);
}

constexpr int AK_BYTES = 32 * 384;
constexpr int ASTAGE = AK_BYTES;

DI void attn_unit(const Params& p, int unit, char* smem) {
  const int tid = threadIdx.x, w = tid >> 6, lane = tid & 63, r = lane & 31, hf = lane >> 5;
  int t0, nkt, nrot, ldv, pos0;
  const u16 *Kg, *VTg;
  if (unit < 512) {
    const int b = unit & 7, g = unit >> 3;
    t0 = NCTX + b * 2048 + g * 32; nkt = 80; nrot = 64; ldv = 2560; pos0 = g * 32;
    Kg = reinterpret_cast<const u16*>(p.ws + OFF_KS) + (size_t)b * 2560 * 192;
    VTg = reinterpret_cast<const u16*>(p.ws + OFF_VTS) + (size_t)b * 128 * 2560;
  } else {
    const int u2 = unit - 512, b = (u2 & 7) + 8 * ((u2 >> 3) & 1), g = u2 >> 4;
    t0 = b * 256 + g * 32; nkt = 8; nrot = 0; ldv = 256; pos0 = 0;
    Kg = reinterpret_cast<const u16*>(p.ws + OFF_KC) + (size_t)b * 256 * 192;
    VTg = reinterpret_cast<const u16*>(p.ws + OFF_VTC) + (size_t)b * 128 * 256;
  }
  const u16* qrow = reinterpret_cast<const u16*>(p.ws + OFF_Q) + (size_t)(t0 + r) * 768 + w * 192;
  bf16x8 qa[8], qr[4];
#pragma unroll
  for (int s = 0; s < 8; ++s) qa[s] = *reinterpret_cast<const bf16x8*>(qrow + 16 * s + 8 * hf);
#pragma unroll
  for (int s = 0; s < 4; ++s) qr[s] = *reinterpret_cast<const bf16x8*>(qrow + 128 + 16 * s + 8 * hf);
  if (nrot > 0) {
    const float* tc = reinterpret_cast<const float*>(p.ws + OFF_ROPE) + (size_t)(pos0 + r) * 32;
    const float* ts = tc + 2048 * 32;
#pragma unroll
    for (int s = 0; s < 2; ++s) {
      bf16x8 n1, n2;
#pragma unroll
      for (int j = 0; j < 8; ++j) {
        float x1 = bf2f((u16)qr[s][j]), x2 = bf2f((u16)qr[s + 2][j]);
        float cs = tc[16 * s + 8 * hf + j], sn = ts[16 * s + 8 * hf + j];
        n1[j] = (short)f2bf(x1 * cs - x2 * sn);
        n2[j] = (short)f2bf(x1 * sn + x2 * cs);
      }
      qr[s] = n1; qr[s + 2] = n2;
    }
  }
  int kg0, kg1, kg2;
  {
    const int L0 = tid, L1 = tid + 256, L2 = tid + 512;
    const int r0 = L0 / 24, c0 = L0 % 24, r1 = L1 / 24, c1 = L1 % 24, r2 = L2 / 24, c2 = L2 % 24;
    kg0 = r0 * 192 + ((c0 & ~7) | ((c0 & 7) ^ ((r0 >> 1) & 7))) * 8;
    kg1 = r1 * 192 + ((c1 & ~7) | ((c1 & 7) ^ ((r1 >> 1) & 7))) * 8;
    kg2 = r2 * 192 + ((c2 & ~7) | ((c2 & 7) ^ ((r2 >> 1) & 7))) * 8;
  }
#define ATT_ISSUE(kt, stage) do { char* sb_ = smem + (stage) * ASTAGE + tid * 16; const u16* kb_ = Kg + (size_t)(kt) * 32 * 192; \
    __builtin_amdgcn_global_load_lds((const unsigned*)(kb_ + kg0), (unsigned*)(sb_), 16, 0, 0); \
    __builtin_amdgcn_global_load_lds((const unsigned*)(kb_ + kg1), (unsigned*)(sb_ + 4096), 16, 0, 0); \
    __builtin_amdgcn_global_load_lds((const unsigned*)(kb_ + kg2), (unsigned*)(sb_ + 8192), 16, 0, 0); } while (0)
  const int ksw = (r >> 1) & 7;
  int koff[4];
#pragma unroll
  for (int j = 0; j < 4; ++j) koff[j] = r * 384 + (((2 * j + hf) ^ ksw) * 16);
  int vtoff[2];
  {
    const int i16 = lane & 15, q4 = i16 >> 2, p4 = i16 & 3, blk = (lane >> 4) & 1;
    const int sw0 = (2 * hf + (q4 >> 1)) & 7;
#pragma unroll
    for (int dl = 0; dl < 2; ++dl) vtoff[dl] = (4 * hf + q4) * 384 + (((4 * dl + 2 * blk + (p4 >> 1)) ^ sw0) * 16) + 8 * (p4 & 1);
  }
  f32x16 o[4];
#pragma unroll
  for (int dt = 0; dt < 4; ++dt)
#pragma unroll
    for (int i = 0; i < 16; ++i) o[dt][i] = 0.f;
  float mrun = 0.f, lrun = 0.f;
  f32x16 negm;
#pragma unroll
  for (int i = 0; i < 16; ++i) negm[i] = 0.f;
  asm volatile("" :: "v"(qa[0]), "v"(qa[1]), "v"(qa[2]), "v"(qa[3]), "v"(qa[4]), "v"(qa[5]), "v"(qa[6]), "v"(qa[7]),
               "v"(qr[0]), "v"(qr[1]), "v"(qr[2]), "v"(qr[3]));
  asm volatile("s_waitcnt vmcnt(0)" ::: "memory");
  ATT_ISSUE(0, 0);
  ATT_ISSUE(1, 1);
  int st = 0;
  int t = 0;
#pragma unroll 1
  for (int seg = 0; seg < 2; ++seg) {
  const int tend = (seg == 0) ? nrot : nkt;
  if (seg == 1 && nrot > 0) {
#pragma unroll
    for (int s4 = 0; s4 < 4; ++s4) qr[s4] = *reinterpret_cast<const bf16x8*>(qrow + 128 + 16 * s4 + 8 * hf);
    asm volatile("" :: "v"(qr[0]), "v"(qr[1]), "v"(qr[2]), "v"(qr[3]));
  }
#pragma unroll 1
  for (; t < tend; ++t) {
    if (t + 1 < nkt) asm volatile("s_waitcnt vmcnt(3)" ::: "memory");
    else asm volatile("s_waitcnt vmcnt(0)" ::: "memory");
    __builtin_amdgcn_s_barrier();
    if (t + 2 < nkt) { const int st2 = (st == 0) ? 2 : st - 1; ATT_ISSUE(t + 2, st2); }
    const char* Ks = smem + st * ASTAGE;
    st = (st == 2) ? 0 : st + 1;
    f32x16 s;
    const unsigned kb = (unsigned)(size_t)Ks;
    const unsigned ka0 = kb + koff[0], ka1 = kb + koff[1], ka2 = kb + koff[2], ka3 = kb + koff[3];
    const unsigned va0 = kb + vtoff[0], va1 = kb + vtoff[1];
    {
      bf16x8 k0, k1, k2, k3, k4, k5, k6, k7, k8, k9, k10, k11;
      asm volatile(
          "ds_read_b128 %0, %12\n\tds_read_b128 %1, %13\n\tds_read_b128 %2, %14\n\tds_read_b128 %3, %15\n\t"
          "ds_read_b128 %4, %12 offset:128\n\tds_read_b128 %5, %13 offset:128\n\tds_read_b128 %6, %14 offset:128\n\tds_read_b128 %7, %15 offset:128\n\t"
          "ds_read_b128 %8, %12 offset:256\n\tds_read_b128 %9, %13 offset:256\n\tds_read_b128 %10, %14 offset:256\n\tds_read_b128 %11, %15 offset:256\n\t"
          "s_waitcnt lgkmcnt(0)"
          : "=&v"(k0), "=&v"(k1), "=&v"(k2), "=&v"(k3), "=&v"(k4), "=&v"(k5), "=&v"(k6), "=&v"(k7), "=&v"(k8), "=&v"(k9), "=&v"(k10), "=&v"(k11)
          : "v"(ka0), "v"(ka1), "v"(ka2), "v"(ka3) : "memory");
      __builtin_amdgcn_s_setprio(1);
      s = MFMA32(k0, qa[0], negm); s = MFMA32(k1, qa[1], s); s = MFMA32(k2, qa[2], s); s = MFMA32(k3, qa[3], s);
      s = MFMA32(k4, qa[4], s); s = MFMA32(k5, qa[5], s); s = MFMA32(k6, qa[6], s); s = MFMA32(k7, qa[7], s);
      s = MFMA32(k8, qr[0], s); s = MFMA32(k9, qr[1], s); s = MFMA32(k10, qr[2], s); s = MFMA32(k11, qr[3], s);
      __builtin_amdgcn_s_setprio(0);
    }
    s16x4 v0, v1, v2, v3, v4, v5, v6, v7, v8, v9, v10, v11, v12, v13, v14, v15;
    asm volatile(
        "ds_read_b64_tr_b16 %0, %16\n\tds_read_b64_tr_b16 %1, %17 offset:3072\n\tds_read_b64_tr_b16 %2, %16 offset:6144\n\tds_read_b64_tr_b16 %3, %17 offset:9216\n\t"
        "ds_read_b64_tr_b16 %4, %17\n\tds_read_b64_tr_b16 %5, %16 offset:3072\n\tds_read_b64_tr_b16 %6, %17 offset:6144\n\tds_read_b64_tr_b16 %7, %16 offset:9216\n\t"
        "ds_read_b64_tr_b16 %8, %16 offset:128\n\tds_read_b64_tr_b16 %9, %17 offset:3200\n\tds_read_b64_tr_b16 %10, %16 offset:6272\n\tds_read_b64_tr_b16 %11, %17 offset:9344\n\t"
        "ds_read_b64_tr_b16 %12, %17 offset:128\n\tds_read_b64_tr_b16 %13, %16 offset:3200\n\tds_read_b64_tr_b16 %14, %17 offset:6272\n\tds_read_b64_tr_b16 %15, %16 offset:9344"
        : "=&v"(v0), "=&v"(v1), "=&v"(v2), "=&v"(v3), "=&v"(v4), "=&v"(v5), "=&v"(v6), "=&v"(v7),
          "=&v"(v8), "=&v"(v9), "=&v"(v10), "=&v"(v11), "=&v"(v12), "=&v"(v13), "=&v"(v14), "=&v"(v15)
        : "v"(va0), "v"(va1) : "memory");
    const float mA = max3f_after_mfma(s[0], s[1], s[2]);
    float mx = max3f(max3f(mA, max3f(s[3], s[4], s[5]), max3f(s[6], s[7], s[8])),
                     max3f(s[9], s[10], s[11]), max3f(max3f(s[12], s[13], s[14]), s[15], s[15]));
    {
      auto sw = __builtin_amdgcn_permlane32_swap(__float_as_uint(mx), __float_as_uint(mx), false, false);
      mx = fmaxf(__uint_as_float(sw[0]), __uint_as_float(sw[1]));
    }
    const bool first = (t == 0);
    if (first || __builtin_amdgcn_ballot_w64(mx > 8.f) != 0ull) {
      const float delta = first ? mx : fmaxf(mx, 0.f);
      mrun += delta;
#pragma unroll
      for (int i = 0; i < 16; ++i) { negm[i] = -mrun; s[i] -= delta; }
      if (!first) {
        const float alpha = __builtin_amdgcn_exp2f(-delta);
        lrun *= alpha;
#pragma unroll
        for (int dt = 0; dt < 4; ++dt)
#pragma unroll
          for (int i = 0; i < 16; ++i) o[dt][i] *= alpha;
      }
    }
    f32x2_t ps2 = {0.f, 0.f};
#pragma unroll
    for (int i = 0; i < 8; ++i) {
      const float e0 = __builtin_amdgcn_exp2f(s[2 * i]), e1 = __builtin_amdgcn_exp2f(s[2 * i + 1]);
      s[2 * i] = e0; s[2 * i + 1] = e1;
      ps2 += f32x2_t{e0, e1};
    }
    lrun += ps2[0] + ps2[1];
    bf16x8 pb[2];
    pb[0] = pack_step(s, 0);
    pb[1] = pack_step(s, 1);
    asm volatile("s_waitcnt lgkmcnt(0)"
                 : "+v"(v0), "+v"(v1), "+v"(v2), "+v"(v3), "+v"(v4), "+v"(v5), "+v"(v6), "+v"(v7),
                   "+v"(v8), "+v"(v9), "+v"(v10), "+v"(v11), "+v"(v12), "+v"(v13), "+v"(v14), "+v"(v15));
    __builtin_amdgcn_s_setprio(1);
    o[0] = MFMA32(__builtin_shufflevector(v0, v1, 0, 1, 2, 3, 4, 5, 6, 7), pb[0], o[0]);
    o[1] = MFMA32(__builtin_shufflevector(v4, v5, 0, 1, 2, 3, 4, 5, 6, 7), pb[0], o[1]);
    o[2] = MFMA32(__builtin_shufflevector(v8, v9, 0, 1, 2, 3, 4, 5, 6, 7), pb[0], o[2]);
    o[3] = MFMA32(__builtin_shufflevector(v12, v13, 0, 1, 2, 3, 4, 5, 6, 7), pb[0], o[3]);
    o[0] = MFMA32(__builtin_shufflevector(v2, v3, 0, 1, 2, 3, 4, 5, 6, 7), pb[1], o[0]);
    o[1] = MFMA32(__builtin_shufflevector(v6, v7, 0, 1, 2, 3, 4, 5, 6, 7), pb[1], o[1]);
    o[2] = MFMA32(__builtin_shufflevector(v10, v11, 0, 1, 2, 3, 4, 5, 6, 7), pb[1], o[2]);
    o[3] = MFMA32(__builtin_shufflevector(v14, v15, 0, 1, 2, 3, 4, 5, 6, 7), pb[1], o[3]);
    __builtin_amdgcn_s_setprio(0);
  }
  }
  __syncthreads();
  lrun += __shfl_xor(lrun, 32);
  const float inv = 1.f / lrun;
#pragma unroll
  for (int dt = 0; dt < 4; ++dt)
#pragma unroll
    for (int i = 0; i < 16; ++i) o[dt][i] *= inv;
  int rr = r;
  asm volatile("" : "+v"(rr));
  const u16* wv = reinterpret_cast<const u16*>(p.ws + OFF_WKVT) + (size_t)(w * 256 + 128) * 128;
  f32x16 at[4];
#pragma unroll
  for (int n2 = 0; n2 < 4; ++n2)
#pragma unroll
    for (int i = 0; i < 16; ++i) at[n2][i] = 0.f;
#pragma unroll
  for (int dt = 0; dt < 4; ++dt)
#pragma unroll
    for (int s2 = 0; s2 < 2; ++s2) {
      const bf16x8 pb = pack_step(o[dt], s2);
#pragma unroll
      for (int n2 = 0; n2 < 4; ++n2) {
        const u16* wp = wv + (size_t)(32 * n2 + rr) * 128 + 32 * dt + 16 * s2 + 4 * hf;
        s16x4 lo = *reinterpret_cast<const s16x4*>(wp);
        s16x4 hi = *reinterpret_cast<const s16x4*>(wp + 8);
        bf16x8 wa = __builtin_shufflevector(lo, hi, 0, 1, 2, 3, 4, 5, 6, 7);
        at[n2] = MFMA32(wa, pb, at[n2]);
      }
    }
  const u16* gbr = reinterpret_cast<const u16*>(p.ws + OFF_Z) + (size_t)(t0 + rr) * ZW + 1984 + w * 128;
  u16* mrow = reinterpret_cast<u16*>(p.ws + OFF_H) + (size_t)(t0 + rr) * 1024 + 512 + w * 128;
#pragma unroll
  for (int n2 = 0; n2 < 4; ++n2)
#pragma unroll
    for (int g4 = 0; g4 < 4; ++g4) {
      const int n = 32 * n2 + 8 * g4 + 4 * hf;
      const s16x4 gb = *reinterpret_cast<const s16x4*>(gbr + n);
      uint2 v;
      v.x = pack2(at[n2][4 * g4] * silu_f(bf2f((u16)gb[0])), at[n2][4 * g4 + 1] * silu_f(bf2f((u16)gb[1])));
      v.y = pack2(at[n2][4 * g4 + 2] * silu_f(bf2f((u16)gb[2])), at[n2][4 * g4 + 3] * silu_f(bf2f((u16)gb[3])));
      *reinterpret_cast<uint2*>(mrow + n) = v;
    }
}

DI void phase_attn(const Params& p, char* smem) {
  for (int u = blockIdx.x; u < 640; u += gridDim.x) attn_unit(p, u, smem);
}

DI void phase_attnout(const Params& p, char* smem) {
  const int tid = threadIdx.x, wid = tid >> 6, lane = tid & 63, wr = wid >> 1, wc = wid & 1, fr = lane & 15, fq = lane >> 4;
  const u16* Z = reinterpret_cast<const u16*>(p.ws + OFF_Z);
  u16* MIX = reinterpret_cast<u16*>(p.ws + OFF_H);
  for (int u = blockIdx.x; u < 640; u += gridDim.x) {
    const int mt = u >> 2, hh = u & 3;
    const u16* A = reinterpret_cast<const u16*>(p.ws + OFF_OLAT) + (size_t)mt * 128 * 512 + hh * 128;
    const u16* W = reinterpret_cast<const u16*>(p.ws + OFF_WKVT) + (size_t)(hh * 256 + 128) * 128;
    f32x4 acc[4][4];
    gemm_mainloop(A, 512, W, 128, 128, smem, acc);
#pragma unroll
    for (int m = 0; m < 4; ++m)
#pragma unroll
      for (int j = 0; j < 4; ++j) {
        const int t = mt * 128 + wr * 64 + m * 16 + fq * 4 + j;
#pragma unroll
        for (int n = 0; n < 4; ++n) {
          const int col = hh * 128 + wc * 64 + n * 16 + fr;
          float gb = silu_f(bf2f(Z[(size_t)t * ZW + 1984 + col]));
          MIX[(size_t)t * 1024 + 512 + col] = f2bf(acc[m][n][j] * gb);
        }
      }
  }
}

DI void phase_out(const Params& p, char* smem) {
  const int tid = threadIdx.x, wid = tid >> 6, lane = tid & 63, wr = wid >> 1, wc = wid & 1, fr = lane & 15, fq = lane >> 4;
  const u16* MIX = reinterpret_cast<const u16*>(p.ws + OFF_H);
  const u16* W = reinterpret_cast<const u16*>(p.ws + OFF_WOT);
  const float* mod = reinterpret_cast<const float*>(p.ws + OFF_MOD);
  float* SS = reinterpret_cast<float*>(p.ws + OFF_SS);
  u16* R = reinterpret_cast<u16*>(p.ws + OFF_Z);
  for (int u = blockIdx.x; u < 160 * 8; u += gridDim.x) {
    const int xcd = u & 7, iu = u >> 3;
    const int mt = (iu >> 3) * 8 + xcd, nt = iu & 7;
    f32x4 acc[4][4];
    gemm_mainloop(MIX + (size_t)mt * 128 * 1024, 1024, W + (size_t)nt * 128 * 1024, 1024, 1024, smem, acc);
    const float* gate = mod + cond_of(mt * 128) * 3072 + 2048 + nt * 128;
    const int col = (tid & 31) * 4;
    float4 xv[16];
#pragma unroll
    for (int i = 0; i < 16; ++i) xv[i] = *reinterpret_cast<const float4*>(xrow(p, mt * 128 + (tid >> 5) + i * 8) + nt * 128 + col);
    const float4 g4 = *reinterpret_cast<const float4*>(gate + col);
    float* stf = reinterpret_cast<float*>(smem);
#pragma unroll
    for (int m = 0; m < 4; ++m)
#pragma unroll
      for (int j = 0; j < 4; ++j) {
        const int row = wr * 64 + m * 16 + fq * 4 + j;
#pragma unroll
        for (int n = 0; n < 4; ++n) stf[row * 128 + ((wc * 64 + n * 16 + fr) ^ (fq * 16))] = acc[m][n][j];
      }
    __syncthreads();
#pragma unroll
    for (int i = 0; i < 16; ++i) {
      const int row = (tid >> 5) + i * 8, sw = ((row >> 2) & 3) * 16, t = mt * 128 + row;
      const float4 y = *reinterpret_cast<const float4*>(stf + row * 128 + (col ^ sw));
      float4 rv;
      rv.x = xv[i].x + g4.x * y.x; rv.y = xv[i].y + g4.y * y.y; rv.z = xv[i].z + g4.z * y.z; rv.w = xv[i].w + g4.w * y.w;
      *reinterpret_cast<uint2*>(R + (size_t)t * 1024 + nt * 128 + col) = make_uint2(pack2(rv.x, rv.y), pack2(rv.z, rv.w));
      float ss = rv.x * rv.x + rv.y * rv.y + rv.z * rv.z + rv.w * rv.w;
#pragma unroll
      for (int o = 16; o > 0; o >>= 1) ss += __shfl_xor(ss, o);
      if ((tid & 31) == 0) SS[(size_t)t * 16 + nt] = ss;
    }
    __syncthreads();
  }
}

DI void phase_final(const Params& p) {
  const int lane = threadIdx.x & 63, wid = threadIdx.x >> 6;
  const float* SS = reinterpret_cast<const float*>(p.ws + OFF_SS);
  const u16* R = reinterpret_cast<const u16*>(p.ws + OFF_Z);
  float4 g[4];
#pragma unroll
  for (int j = 0; j < 4; ++j) g[j] = *reinterpret_cast<const float4*>(p.final_g + j * 256 + lane * 4);
  for (int t = (blockIdx.x * 4 + wid) * 4; t < NTOK; t += gridDim.x * 16) {
    uint2 rb[4][4];
    float ssv[4];
#pragma unroll
    for (int k = 0; k < 4; ++k) {
      ssv[k] = (lane < 8) ? SS[(size_t)(t + k) * 16 + lane] : 0.f;
#pragma unroll
      for (int j = 0; j < 4; ++j) rb[k][j] = *reinterpret_cast<const uint2*>(R + (size_t)(t + k) * 1024 + j * 256 + lane * 4);
    }
#pragma unroll
    for (int k = 0; k < 4; ++k) {
      float ss = ssv[k];
#pragma unroll
      for (int o = 4; o > 0; o >>= 1) ss += __shfl_xor(ss, o);
      ss = __shfl(ss, 0);
      const float rstd = rsqrtf(ss * (1.f / 1024.f) + EPSF);
      float* row = p.out + (size_t)(t + k) * 1024;
#pragma unroll
      for (int j = 0; j < 4; ++j) {
        float4 v;
        v.x = bf2f((u16)(rb[k][j].x & 0xffff)) * rstd * g[j].x; v.y = bf2f((u16)(rb[k][j].x >> 16)) * rstd * g[j].y;
        v.z = bf2f((u16)(rb[k][j].y & 0xffff)) * rstd * g[j].z; v.w = bf2f((u16)(rb[k][j].y >> 16)) * rstd * g[j].w;
        *reinterpret_cast<float4*>(row + j * 256 + lane * 4) = v;
      }
    }
  }
}

#define XB_TMO      128
#define XB_XCNT(j)  (256  + 64 * (j))
#define XB_XSUB(j)  (1280 + 64 * (j))
#define XB_XGEN(j)  (2304 + 64 * (j))
#define XB_TOP      3328
#define XB_TOPGEN   3392
#define XB_SPIN_CAP (1u << 22)
DI unsigned xb_ld(unsigned* p) { return __hip_atomic_load(p, __ATOMIC_RELAXED, __HIP_MEMORY_SCOPE_AGENT); }
DI unsigned xb_add(unsigned* p, unsigned v) { return __hip_atomic_fetch_add(p, v, __ATOMIC_RELAXED, __HIP_MEMORY_SCOPE_AGENT); }
DI unsigned xb_xcc_id() { return (unsigned)__builtin_amdgcn_s_getreg((3 << 11) | 20) & 0xFu; }
#define XB_SPIN(cond, bar) do { unsigned _sp = 0; while (cond) { __builtin_amdgcn_s_sleep(1); \
    if ((++_sp & 255u) == 0u) { if (xb_ld(&(bar)[XB_TMO])) break; if (_sp > XB_SPIN_CAP) { atomicAdd(&(bar)[XB_TMO], 1u); break; } } } } while (0)
struct XcdBarrier { unsigned* bar; unsigned x, nloc, nx; };
DI void xcd_barrier_post(XcdBarrier& b, unsigned* bar) {
  b.bar = bar; b.x = xb_xcc_id(); b.nloc = 0u; b.nx = 0u;
  if (threadIdx.x == 0) (void)xb_add(&bar[XB_XCNT(b.x)], 1u);
}
DI void xcd_barrier_complete(unsigned* bar, unsigned x, unsigned& nloc, unsigned& nx) {
  const unsigned G = gridDim.x;
  unsigned sum, cnt, mine, sp = 0u;
  for (;;) {
    sum = 0u; cnt = 0u; mine = 0u;
#pragma unroll
    for (unsigned j = 0; j < 16; ++j) { const unsigned c = xb_ld(&bar[XB_XCNT(j)]); sum += c; cnt += (c > 0u) ? 1u : 0u; mine = (j == x) ? c : mine; }
    if (sum == G) break;
    __builtin_amdgcn_s_sleep(1);
    if ((++sp & 255u) == 0u) { if (xb_ld(&bar[XB_TMO])) break; if (sp > XB_SPIN_CAP) { atomicAdd(&bar[XB_TMO], 1u); break; } }
  }
  nloc = mine > 0u ? mine : 1u; nx = cnt > 0u ? cnt : 1u;
}
DI void xcd_barrier(XcdBarrier& b) {
  asm volatile("s_waitcnt vmcnt(0)" ::: "memory");
  __syncthreads();
  if (threadIdx.x == 0) {
    unsigned* bar = b.bar;
    __builtin_amdgcn_s_waitcnt(0);
    if (b.nloc == 0u) xcd_barrier_complete(bar, b.x, b.nloc, b.nx);
    const unsigned nloc = b.nloc, nx = b.nx;
    const unsigned old = xb_add(&bar[XB_XSUB(b.x)], 1u);
    const unsigned gen = old / nloc;
    if (old + 1u == (gen + 1u) * nloc) {
      __builtin_amdgcn_fence(__ATOMIC_RELEASE, "agent");
      asm volatile("s_waitcnt vmcnt(0)" ::: "memory");
      const unsigned og = xb_add(&bar[XB_TOP], 1u);
      const unsigned tg = og / nx;
      if (og + 1u == (tg + 1u) * nx) xb_add(&bar[XB_TOPGEN], 1u);
      else XB_SPIN(xb_ld(&bar[XB_TOPGEN]) == tg, bar);
      __builtin_amdgcn_fence(__ATOMIC_ACQUIRE, "agent");
      xb_add(&bar[XB_XGEN(b.x)], 1u);
      asm volatile("s_waitcnt vmcnt(0)" ::: "memory");
    } else {
      XB_SPIN(xb_ld(&bar[XB_XGEN(b.x)]) == gen, bar);
      __builtin_amdgcn_fence(__ATOMIC_ACQUIRE, "agent");
      asm volatile("s_waitcnt vmcnt(0)" ::: "memory");
    }
  }
  __syncthreads();
}

typedef const __attribute__((address_space(4))) Params* KargPtr;
DI Params load_params() {
#if defined(__HIP_DEVICE_COMPILE__)
  KargPtr pp = (KargPtr)__builtin_amdgcn_kernarg_segment_ptr();
  asm volatile("" : "+s"(pp));
  Params r;
  r.x_prompt = pp->x_prompt;
  r.x_sample = pp->x_sample;
  r.cache_ckv = pp->cache_ckv;
  r.cache_krope = pp->cache_krope;
  r.c = pp->c;
  r.c_ctx = pp->c_ctx;
  r.norm_g = pp->norm_g;
  r.w_ada = pp->w_ada;
  r.b_ada = pp->b_ada;
  r.w_in = pp->w_in;
  r.w_s = pp->w_s;
  r.b_s = pp->b_s;
  r.g_v = pp->g_v;
  r.q_norm_g = pp->q_norm_g;
  r.w_uq = pp->w_uq;
  r.kv_norm_g = pp->kv_norm_g;
  r.w_ukv = pp->w_ukv;
  r.w_o = pp->w_o;
  r.final_g = pp->final_g;
  r.out = pp->out;
  r.ws = pp->ws;
  return r;
#else
  return Params{};
#endif
}

template <int LO, int HI>
__global__ void __launch_bounds__(NT, 2) fwd_kernel(Params p_in) {
  __shared__ __attribute__((aligned(16))) char smem[65536];
  XcdBarrier xb;
  if constexpr (LO < HI) {
    const Params p = load_params();
    xcd_barrier_post(xb, reinterpret_cast<unsigned*>(p.ws + OFF_BAR));
    if (p.out == nullptr) cg::this_grid().sync();
  }
#ifndef REP_PHASE
#define REP_PHASE -1
#endif
#define PHASE(N, CALL) if constexpr (LO <= N && N <= HI) { { const Params p = load_params(); CALL; if constexpr (N == REP_PHASE && LO < HI) { CALL; } } if constexpr (N < HI) xcd_barrier(xb); }
  PHASE(0, phase_prep(p, smem))
  PHASE(1, phase_h(p))
  PHASE(2, phase_gemm1(p, smem))
  PHASE(3, phase_local(p, smem))
  PHASE(4, phase_attn(p, smem))
  PHASE(5, phase_out(p, smem))
  PHASE(6, phase_final(p))
}

template __global__ void fwd_kernel<2, 2>(Params);

extern "C" void kernel_launch(void* const* d_in, const int* in_sizes, int n_in, void* d_out, int out_size, void* d_ws,
                              size_t ws_size, hipStream_t stream) {
  Params p{};
  p.x_prompt = (const float*)d_in[0]; p.x_sample = (const float*)d_in[1]; p.cache_ckv = (const float*)d_in[2];
  p.cache_krope = (const float*)d_in[3]; p.c = (const float*)d_in[4]; p.c_ctx = (const float*)d_in[5];
  p.norm_g = (const float*)d_in[6]; p.w_ada = (const float*)d_in[7]; p.b_ada = (const float*)d_in[8];
  p.w_in = (const float*)d_in[9]; p.w_s = (const float*)d_in[10]; p.b_s = (const float*)d_in[11];
  p.g_v = (const float*)d_in[12]; p.q_norm_g = (const float*)d_in[13]; p.w_uq = (const float*)d_in[14];
  p.kv_norm_g = (const float*)d_in[15]; p.w_ukv = (const float*)d_in[16]; p.w_o = (const float*)d_in[17];
  p.final_g = (const float*)d_in[18];
  p.out = (float*)d_out;
  p.ws = (char*)d_ws;
  if (ws_size < WS_TOTAL) { fprintf(stderr, "workspace too small: %zu < %zu\n", ws_size, WS_TOTAL); return; }
#if 0
  hipLaunchKernelGGL((fwd_kernel<0, 0>), dim3(512), dim3(NT), 0, stream, p);
  hipLaunchKernelGGL((fwd_kernel<1, 1>), dim3(512), dim3(NT), 0, stream, p);
  hipLaunchKernelGGL((fwd_kernel<2, 2>), dim3(512), dim3(NT), 0, stream, p);
  hipLaunchKernelGGL((fwd_kernel<3, 3>), dim3(512), dim3(NT), 0, stream, p);
  hipLaunchKernelGGL((fwd_kernel<4, 4>), dim3(512), dim3(NT), 0, stream, p);
  hipLaunchKernelGGL((fwd_kernel<5, 5>), dim3(512), dim3(NT), 0, stream, p);
  hipLaunchKernelGGL((fwd_kernel<6, 6>), dim3(512), dim3(NT), 0, stream, p);
  hipLaunchKernelGGL((fwd_kernel<7, 7>), dim3(512), dim3(NT), 0, stream, p);
#else
  static int grid_blocks = 0;
  if (!grid_blocks) {
    int dev = 0, cus = 0, per_cu = 0;
    hipGetDevice(&dev);
    hipDeviceGetAttribute(&cus, hipDeviceAttributeMultiprocessorCount, dev);
    hipOccupancyMaxActiveBlocksPerMultiprocessor(&per_cu, fwd_kernel<0, 6>, NT, 0);
    if (per_cu > 2) per_cu = 2;
    grid_blocks = cus * per_cu;
  }
  hipMemsetAsync((char*)d_ws + OFF_BAR, 0, (3456 + 256) * 4, stream);
  void* args[] = {&p};
  hipError_t e = hipLaunchCooperativeKernel((void*)fwd_kernel<0, 6>, dim3(grid_blocks), dim3(NT), args, 0, stream);
  if (e != hipSuccess) fprintf(stderr, "cooperative launch failed: %s (grid %d)\n", hipGetErrorString(e), grid_blocks);
#endif
}
```

```cpp
#include <hip/hip_runtime.h>
#include <hip/hip_cooperative_groups.h>
#include <cstdio>
namespace cg = cooperative_groups;

typedef unsigned short u16;
using bf16x8 = __attribute__((ext_vector_type(8))) short;
using s16x4  = __attribute__((ext_vector_type(4))) short;
using f32x4  = __attribute__((ext_vector_type(4))) float;
using f32x16 = __attribute__((ext_vector_type(16))) float;
using u32x4  = __attribute__((ext_vector_type(4))) unsigned;
#define DI __device__ __forceinline__

constexpr int NT = 256;
constexpr int NTOK = 20480;
constexpr int NCTX = 4096;
constexpr int DM = 1024;
constexpr int ZW = 2560;
constexpr int INW = 2496;
constexpr float EPSF = 1e-6f;
constexpr float QSCALE = 0.07216878364870322f * 1.4426950408889634f;

constexpr size_t OFF_MOD   = 0;
constexpr size_t OFF_WINT  = OFF_MOD   + 9 * 3072 * 4;
constexpr size_t OFF_WOT   = OFF_WINT  + (size_t)ZW * 1024 * 2;
constexpr size_t OFF_WQT   = OFF_WOT   + (size_t)1024 * 1024 * 2;
constexpr size_t OFF_WKVT  = OFF_WQT   + (size_t)768 * 256 * 2;
constexpr size_t OFF_WSB   = OFF_WKVT  + (size_t)1024 * 128 * 2;
constexpr size_t OFF_ROPE  = OFF_WSB   + (size_t)4 * 128 * 128 * 2;
constexpr size_t OFF_H     = OFF_ROPE  + (size_t)2048 * 32 * 2 * 4;
constexpr size_t OFF_Z     = OFF_H     + (size_t)NTOK * 1024 * 2;
constexpr size_t OFF_Q     = OFF_Z     + (size_t)NTOK * ZW * 2;
constexpr size_t OFF_KC    = OFF_Q     + (size_t)NTOK * 768 * 2;
constexpr size_t OFF_VTC   = OFF_KC    + (size_t)16 * 256 * 192 * 2;
constexpr size_t OFF_KS    = OFF_VTC   + (size_t)16 * 128 * 256 * 2;
constexpr size_t OFF_VTS   = OFF_KS    + (size_t)8 * 2560 * 192 * 2;
constexpr size_t OFF_OLAT  = OFF_VTS   + (size_t)8 * 128 * 2560 * 2;
constexpr size_t OFF_SS    = OFF_OLAT  + (size_t)NTOK * 512 * 2;
constexpr size_t OFF_BAR   = OFF_SS    + (size_t)NTOK * 16 * 4;
constexpr size_t OFF_CNT   = OFF_BAR   + 3456 * 4;
constexpr size_t WS_TOTAL  = OFF_CNT   + 256 * 4;

struct Params {
  const float *x_prompt, *x_sample, *cache_ckv, *cache_krope, *c, *c_ctx, *norm_g, *w_ada, *b_ada, *w_in, *w_s, *b_s,
      *g_v, *q_norm_g, *w_uq, *kv_norm_g, *w_ukv, *w_o, *final_g;
  float* out;
  char* ws;
};

typedef float f32x2_t __attribute__((ext_vector_type(2)));
DI float max3f(float a, float b, float c) { float r; asm("v_max3_f32 %0, %1, %2, %3" : "=v"(r) : "v"(a), "v"(b), "v"(c)); return r; }
DI float max3f_after_mfma(float a, float b, float c) { float r; asm volatile("s_nop 11\n\tv_max3_f32 %0, %1, %2, %3" : "=v"(r) : "v"(a), "v"(b), "v"(c)); return r; }
DI int opaque_tid() { int t = threadIdx.x; asm volatile("" : "+v"(t)); return t; }
typedef __bf16 bf16x2_t __attribute__((ext_vector_type(2)));
typedef float f32x2c_t __attribute__((ext_vector_type(2)));
DI unsigned pack2(float a, float b) { f32x2c_t v = {a, b}; return __builtin_bit_cast(unsigned, __builtin_convertvector(v, bf16x2_t)); }
DI u16 f2bf(float x) { return (u16)(pack2(x, 0.f) & 0xffffu); }
DI float bf2f(u16 v) { return __uint_as_float(((unsigned)v) << 16); }
DI float gelu_f(float x) { float u = 0.7978845608028654f * (x + 0.044715f * x * x * x); return x * __builtin_amdgcn_rcpf(1.f + __expf(-2.f * u)); }
DI float silu_f(float x) { return x * __builtin_amdgcn_rcpf(1.f + __expf(-x)); }
DI const float* xrow(const Params& p, int t) { return t < NCTX ? p.x_prompt + (size_t)t * DM : p.x_sample + (size_t)(t - NCTX) * DM; }
DI int cond_of(int t) { return t < NCTX ? 8 : ((t - NCTX) >> 11); }

#define MFMA16(a, b, c) __builtin_amdgcn_mfma_f32_16x16x32_bf16((a), (b), (c), 0, 0, 0)
#define MFMA32(a, b, c) __builtin_amdgcn_mfma_f32_32x32x16_bf16((a), (b), (c), 0, 0, 0)

DI int lds_byte(int r, int c) {
  int st = (r >> 4) * 2 + (c >> 5), rr = r & 15, cc = c & 31, ob = rr * 64 + cc * 2;
  return st * 1024 + (ob ^ (((ob >> 9) & 1) << 5));
}
DI void stage_rc(int b, int& R, int& C) {
  int st = b >> 10, sb = b & 1023, swz = sb ^ (((sb >> 9) & 1) << 5);
  R = (st >> 1) * 16 + (swz >> 6); C = (st & 1) * 32 + ((swz & 63) >> 1);
}

DI void gemm_stage(const u16* A, int lda, const u16* Bt, int ldb, int kt, char* buf, int tid) {
#pragma unroll
  for (int i = 0; i < 4; ++i) {
    int b = tid * 16 + i * 4096, r, c; stage_rc(b, r, c);
    __builtin_amdgcn_global_load_lds((const unsigned*)(A + (size_t)r * lda + kt * 64 + c), (unsigned*)(buf + b), 16, 0, 0);
    __builtin_amdgcn_global_load_lds((const unsigned*)(Bt + (size_t)r * ldb + kt * 64 + c), (unsigned*)(buf + 16384 + b), 16, 0, 0);
  }
}

DI void gemm_mainloop(const u16* A, int lda, const u16* Bt, int ldb, int K, char* smem, f32x4 (&acc)[4][4], bool staged0 = false, int tid_in = -1) {
  const int tid = tid_in < 0 ? (int)threadIdx.x : tid_in, wid = tid >> 6, lane = tid & 63, wr = wid >> 1, wc = wid & 1, fr = lane & 15, fq = lane >> 4;
#pragma unroll
  for (int m = 0; m < 4; ++m)
#pragma unroll
    for (int n = 0; n < 4; ++n) acc[m][n] = f32x4{0.f, 0.f, 0.f, 0.f};
  const int nt = K >> 6;
  if (!staged0) gemm_stage(A, lda, Bt, ldb, 0, smem, tid);
  for (int t = 0; t < nt; ++t) {
    asm volatile("s_waitcnt vmcnt(0)" ::: "memory");
    __syncthreads();
    if (t + 1 < nt) gemm_stage(A, lda, Bt, ldb, t + 1, smem + ((t + 1) & 1) * 32768, tid);
    const char* sa = smem + (t & 1) * 32768;
    const char* sb = sa + 16384;
#pragma unroll
    for (int k = 0; k < 2; ++k) {
      bf16x8 af[4], bfr[4];
#pragma unroll
      for (int m = 0; m < 4; ++m) af[m] = *reinterpret_cast<const bf16x8*>(sa + lds_byte(wr * 64 + m * 16 + fr, k * 32 + fq * 8));
#pragma unroll
      for (int n = 0; n < 4; ++n) bfr[n] = *reinterpret_cast<const bf16x8*>(sb + lds_byte(wc * 64 + n * 16 + fr, k * 32 + fq * 8));
#pragma unroll
      for (int m = 0; m < 4; ++m)
#pragma unroll
        for (int n = 0; n < 4; ++n) acc[m][n] = MFMA16(af[m], bfr[n], acc[m][n]);
    }
  }
  __syncthreads();
}

DI void store_tile_bf16(f32x4 (&acc)[4][4], char* smem, u16* dst, int ldc, const float* rowscale, int tid_in = -1) {
  const int tid = tid_in < 0 ? (int)threadIdx.x : tid_in, wid = tid >> 6, lane = tid & 63, wr = wid >> 1, wc = wid & 1, fr = lane & 15, fq = lane >> 4;
  u16* st = reinterpret_cast<u16*>(smem);
#pragma unroll
  for (int m = 0; m < 4; ++m)
#pragma unroll
    for (int j = 0; j < 4; ++j) {
      int row = wr * 64 + m * 16 + fq * 4 + j;
      float rs = rowscale ? rowscale[row] : 1.f;
#pragma unroll
      for (int n = 0; n < 4; ++n) st[row * 136 + wc * 64 + n * 16 + fr] = f2bf(acc[m][n][j] * rs);
    }
  __syncthreads();
#pragma unroll
  for (int i = 0; i < 8; ++i) {
    int c = tid + i * 256, row = c >> 4, off = c & 15;
    *reinterpret_cast<uint4*>(dst + (size_t)row * ldc + off * 8) = *reinterpret_cast<const uint4*>(smem + row * 272 + off * 16);
  }
  __syncthreads();
}

DI void prep_mod(const Params& p, int unit, float* sm) {
  const int tid = threadIdx.x;
  for (int e = tid; e < 9 * 1024; e += NT) {
    int i = e >> 10, k = e & 1023;
    float v = (i < 8) ? p.c[i * 1024 + k] : p.c_ctx[k];
    sm[e] = silu_f(v);
  }
  __syncthreads();
  const int c4 = tid & 7, kg = tid >> 3, n0 = unit * 32 + c4 * 4;
  float acc[9][4];
#pragma unroll
  for (int i = 0; i < 9; ++i) { acc[i][0] = acc[i][1] = acc[i][2] = acc[i][3] = 0.f; }
#pragma unroll 4
  for (int j = 0; j < 32; ++j) {
    int k = j * 32 + kg;
    float4 w = *reinterpret_cast<const float4*>(p.w_ada + (size_t)k * 3072 + n0);
#pragma unroll
    for (int i = 0; i < 9; ++i) {
      float s = sm[i * 1024 + k];
      acc[i][0] += s * w.x; acc[i][1] += s * w.y; acc[i][2] += s * w.z; acc[i][3] += s * w.w;
    }
  }
  __syncthreads();
#pragma unroll
  for (int i = 0; i < 9; ++i)
#pragma unroll
    for (int e = 0; e < 4; ++e) sm[(kg * 36 + i * 4 + e) * 8 + c4] = acc[i][e];
  __syncthreads();
  float* mod = reinterpret_cast<float*>(p.ws + OFF_MOD);
  for (int o = tid; o < 288; o += NT) {
    int ie = o >> 3, cc = o & 7;
    float s = 0.f;
    for (int g = 0; g < 32; ++g) s += sm[(g * 36 + ie) * 8 + cc];
    int i = ie >> 2, e = ie & 3, n = unit * 32 + cc * 4 + e;
    mod[i * 3072 + n] = s + p.b_ada[n];
  }
  __syncthreads();
}

DI void transpose_unit(const float* src, int ldsrc, int ncols_valid, u16* dst, int lddst, int k0, int n0, float* sm) {
  const int tid = threadIdx.x;
  for (int e = tid; e < 64 * 16; e += NT) {
    int kk = e >> 4, c4 = e & 15, n = n0 + c4 * 4;
    float4 v = (n < ncols_valid) ? *reinterpret_cast<const float4*>(src + (size_t)(k0 + kk) * ldsrc + n) : make_float4(0.f, 0.f, 0.f, 0.f);
    float* d = sm + kk * 65 + c4 * 4;
    d[0] = v.x; d[1] = v.y; d[2] = v.z; d[3] = v.w;
  }
  __syncthreads();
  const int nn = tid >> 2, seg = tid & 3;
  unsigned w[8];
#pragma unroll
  for (int i = 0; i < 8; ++i) w[i] = pack2(sm[(seg * 16 + 2 * i) * 65 + nn], sm[(seg * 16 + 2 * i + 1) * 65 + nn]);
  uint4* o = reinterpret_cast<uint4*>(dst + (size_t)(n0 + nn) * lddst + k0 + seg * 16);
  o[0] = make_uint4(w[0], w[1], w[2], w[3]);
  o[1] = make_uint4(w[4], w[5], w[6], w[7]);
  __syncthreads();
}

DI void prep_wq(const Params& p, int unit) {
  const int c = threadIdx.x, h = unit / 192, r = unit % 192;
  const float g = p.q_norm_g[c] * QSCALE;
  float v;
  if (r < 128) {
    const float4* a = reinterpret_cast<const float4*>(p.w_uq + (size_t)c * 768 + h * 192);
    const float4* b = reinterpret_cast<const float4*>(p.w_ukv + (size_t)r * 1024 + h * 256);
    float s = 0.f;
#pragma unroll 8
    for (int j = 0; j < 32; ++j) { float4 x = a[j], y = b[j]; s += x.x * y.x + x.y * y.y + x.z * y.z + x.w * y.w; }
    v = s;
  } else {
    v = p.w_uq[(size_t)c * 768 + h * 192 + r];
  }
  reinterpret_cast<u16*>(p.ws + OFF_WQT)[unit * 256 + c] = f2bf(v * g);
}

DI void prep_cache(const Params& p, int unit, float* sm) {
  const int tid = threadIdx.x, b = unit >> 3, j0 = (unit & 7) * 64;
  u16* Ks = reinterpret_cast<u16*>(p.ws + OFF_KS) + (size_t)b * 2560 * 192;
  u16* VT = reinterpret_cast<u16*>(p.ws + OFF_VTS) + (size_t)b * 128 * 2560;
  const float* ck = p.cache_ckv + ((size_t)b * 512 + j0) * 128;
  const float* kr = p.cache_krope + ((size_t)b * 512 + j0) * 64;
  for (int e = tid; e < 64 * 32; e += NT) {
    int j = e >> 5, c4 = e & 31;
    float4 v = *reinterpret_cast<const float4*>(ck + (size_t)j * 128 + c4 * 4);
    uint2 o; o.x = pack2(v.x, v.y); o.y = pack2(v.z, v.w);
    *reinterpret_cast<uint2*>(Ks + (size_t)(2048 + j0 + j) * 192 + c4 * 4) = o;
  }
  for (int e = tid; e < 64 * 16; e += NT) {
    int j = e >> 4, c4 = e & 15;
    float4 v = *reinterpret_cast<const float4*>(kr + (size_t)j * 64 + c4 * 4);
    uint2 o; o.x = pack2(v.x, v.y); o.y = pack2(v.z, v.w);
    *reinterpret_cast<uint2*>(Ks + (size_t)(2048 + j0 + j) * 192 + 128 + c4 * 4) = o;
  }
}

DI void phase_prep(const Params& p, char* smem) {
  float* sm = reinterpret_cast<float*>(smem);
  const int tid = threadIdx.x;
  for (int u = blockIdx.x; u < 1888; u += gridDim.x) {
    int v = u;
    if (v < 96) { prep_mod(p, v, sm); continue; }
    v -= 96;
    if (v < 640) { transpose_unit(p.w_in, INW, INW, reinterpret_cast<u16*>(p.ws + OFF_WINT), 1024, (v & 15) * 64, (v >> 4) * 64, sm); continue; }
    v -= 640;
    if (v < 256) { transpose_unit(p.w_o, 1024, 1024, reinterpret_cast<u16*>(p.ws + OFF_WOT), 1024, (v & 15) * 64, (v >> 4) * 64, sm); continue; }
    v -= 256;
    if (v < 768) { prep_wq(p, v); continue; }
    v -= 768;
    if (v < 32) { transpose_unit(p.w_ukv, 1024, 1024, reinterpret_cast<u16*>(p.ws + OFF_WKVT), 128, (v & 1) * 64, (v >> 1) * 64, sm); continue; }
    v -= 32;
    if (v < 16) {
      u16* d = reinterpret_cast<u16*>(p.ws + OFF_WSB);
      for (int e = v * 4096 + tid; e < (v + 1) * 4096; e += NT) d[e] = f2bf(p.w_s[e]);
      continue;
    }
    v -= 16;
    if (v < 64) { prep_cache(p, v, sm); continue; }
    v -= 64;
    {
      float* tc = reinterpret_cast<float*>(p.ws + OFF_ROPE);
      float* ts = tc + 2048 * 32;
      for (int e = v * 4096 + tid; e < (v + 1) * 4096; e += NT) {
        int pos = e >> 5, i = e & 31;
        float inv = powf(10000.f, -(float)(i & 15) / 16.f);
        float a = (float)((i < 16) ? (pos >> 6) : (pos & 63)) * inv;
        tc[e] = cosf(a); ts[e] = sinf(a);
      }
    }
  }
}

DI void phase_h(const Params& p) {
  const int lane = threadIdx.x & 63, wid = threadIdx.x >> 6;
  const float* mod = reinterpret_cast<const float*>(p.ws + OFF_MOD);
  u16* H = reinterpret_cast<u16*>(p.ws + OFF_H);
  for (int t = (blockIdx.x * 4 + wid) * 2; t < NTOK; t += gridDim.x * 8) {
    float4 v[2][4];
#pragma unroll
    for (int k = 0; k < 2; ++k) {
      const float* x = xrow(p, t + k);
#pragma unroll
      for (int j = 0; j < 4; ++j) v[k][j] = *reinterpret_cast<const float4*>(x + j * 256 + lane * 4);
    }
    const float* md = mod + cond_of(t) * 3072;
    float4 g[4], sh[4], sc[4];
#pragma unroll
    for (int j = 0; j < 4; ++j) {
      const int c = j * 256 + lane * 4;
      g[j] = *reinterpret_cast<const float4*>(p.norm_g + c);
      sh[j] = *reinterpret_cast<const float4*>(md + c);
      sc[j] = *reinterpret_cast<const float4*>(md + 1024 + c);
    }
#pragma unroll
    for (int k = 0; k < 2; ++k) {
      float ss = 0.f;
#pragma unroll
      for (int j = 0; j < 4; ++j) ss += v[k][j].x * v[k][j].x + v[k][j].y * v[k][j].y + v[k][j].z * v[k][j].z + v[k][j].w * v[k][j].w;
#pragma unroll
      for (int o = 32; o > 0; o >>= 1) ss += __shfl_xor(ss, o);
      const float rstd = rsqrtf(ss * (1.f / 1024.f) + EPSF);
#pragma unroll
      for (int j = 0; j < 4; ++j) {
        const int c = j * 256 + lane * 4;
        float a0 = v[k][j].x * rstd * g[j].x * (1.f + sc[j].x) + sh[j].x;
        float a1 = v[k][j].y * rstd * g[j].y * (1.f + sc[j].y) + sh[j].y;
        float a2 = v[k][j].z * rstd * g[j].z * (1.f + sc[j].z) + sh[j].z;
        float a3 = v[k][j].w * rstd * g[j].w * (1.f + sc[j].w) + sh[j].w;
        uint2 o; o.x = pack2(a0, a1); o.y = pack2(a2, a3);
        *reinterpret_cast<uint2*>(H + (size_t)(t + k) * 1024 + c) = o;
      }
    }
  }
}

DI void phase_gemm1(const Params& p, char* smem) {
  const u16* H = reinterpret_cast<const u16*>(p.ws + OFF_H);
  const u16* W = reinterpret_cast<const u16*>(p.ws + OFF_WINT);
  u16* Z = reinterpret_cast<u16*>(p.ws + OFF_Z);
  for (int u = blockIdx.x; u < 160 * 20; u += gridDim.x) {
    const int xcd = u & 7, iu = u >> 3;
    int mt = (iu / 20) * 8 + xcd, nt = iu % 20;
    f32x4 acc[4][4];
    gemm_mainloop(H + (size_t)mt * 128 * 1024, 1024, W + (size_t)nt * 128 * 1024, 1024, 1024, smem, acc);
    store_tile_bf16(acc, smem, Z + (size_t)mt * 128 * ZW + nt * 128, ZW, nullptr);
  }
}

DI void chunk_mlp_unit(const Params& p, int unit, char* smem) {
  const int tid = opaque_tid(), wid = tid >> 6, lane = tid & 63, fr = lane & 15, fq = lane >> 4;
  const int ck = unit >> 2, hh = unit & 3, t0 = ck * 128;
  const u16* Z = reinterpret_cast<const u16*>(p.ws + OFF_Z);
  u16* MIX = reinterpret_cast<u16*>(p.ws + OFF_H);
  u16* vnT = reinterpret_cast<u16*>(smem);
  {
    const int q = tid >> 1, half = tid & 1;
    const u16* src = Z + (size_t)(t0 + q) * ZW + 512 + hh * 128 + half * 64;
    float g[64];
    float ss = 0.f;
#pragma unroll
    for (int i = 0; i < 8; ++i) {
      bf16x8 v = *reinterpret_cast<const bf16x8*>(src + i * 8);
#pragma unroll
      for (int j = 0; j < 8; ++j) { float x = gelu_f(bf2f((u16)v[j])); g[i * 8 + j] = x; ss += x * x; }
    }
    ss += __shfl_xor(ss, 1);
    const float rstd = rsqrtf(ss * (1.f / 128.f) + EPSF);
    const float* gv = p.g_v + hh * 128 + half * 64;
#pragma unroll
    for (int i = 0; i < 64; ++i) vnT[(half * 64 + i) * 136 + q] = f2bf(g[i] * rstd * gv[i]);
  }
  __syncthreads();
  const u16* wsb = reinterpret_cast<const u16*>(p.ws + OFF_WSB) + hh * 16384;
  f32x4 acc[2][8];
#pragma unroll
  for (int m = 0; m < 2; ++m)
#pragma unroll
    for (int n = 0; n < 8; ++n) acc[m][n] = f32x4{0.f, 0.f, 0.f, 0.f};
#pragma unroll
  for (int ks = 0; ks < 4; ++ks) {
    bf16x8 a[2];
#pragma unroll
    for (int m = 0; m < 2; ++m) a[m] = *reinterpret_cast<const bf16x8*>(wsb + (wid * 32 + m * 16 + fr) * 128 + ks * 32 + fq * 8);
#pragma unroll
    for (int n = 0; n < 8; ++n) {
      bf16x8 b = *reinterpret_cast<const bf16x8*>(vnT + (n * 16 + fr) * 136 + ks * 32 + fq * 8);
#pragma unroll
      for (int m = 0; m < 2; ++m) acc[m][n] = MFMA16(a[m], b, acc[m][n]);
    }
  }
  bf16x8 uu[8], gg[8];
#pragma unroll
  for (int i = 0; i < 8; ++i) {
    const int c = tid + i * 256, row = c >> 4, col = (c & 15) * 8;
    const u16* zr = Z + (size_t)(t0 + row) * ZW + hh * 128 + col;
    uu[i] = *reinterpret_cast<const bf16x8*>(zr);
    gg[i] = *reinterpret_cast<const bf16x8*>(zr + 1024);
  }
  __syncthreads();
  float* stf = reinterpret_cast<float*>(smem);
#pragma unroll
  for (int m = 0; m < 2; ++m)
#pragma unroll
    for (int j = 0; j < 4; ++j) {
      const int pr = wid * 32 + m * 16 + fq * 4 + j;
      const float bs = p.b_s[hh * 128 + pr];
#pragma unroll
      for (int n = 0; n < 8; ++n) stf[pr * 128 + ((n * 16 + fr) ^ (fq * 16))] = acc[m][n][j] + bs;
    }
  __syncthreads();
#pragma unroll
  for (int i = 0; i < 8; ++i) {
    const int c = tid + i * 256, row = c >> 4, col = (c & 15) * 8, sw = ((row >> 2) & 3) * 16;
    const float4 m0 = *reinterpret_cast<const float4*>(stf + row * 128 + (col ^ sw));
    const float4 m1 = *reinterpret_cast<const float4*>(stf + row * 128 + ((col + 4) ^ sw));
    const float mm[8] = {m0.x, m0.y, m0.z, m0.w, m1.x, m1.y, m1.z, m1.w};
    float o8[8];
#pragma unroll
    for (int k = 0; k < 8; ++k) o8[k] = gelu_f(bf2f((u16)uu[i][k])) * mm[k] * silu_f(bf2f((u16)gg[i][k]));
    uint4 ov = make_uint4(pack2(o8[0], o8[1]), pack2(o8[2], o8[3]), pack2(o8[4], o8[5]), pack2(o8[6], o8[7]));
    *reinterpret_cast<uint4*>(MIX + (size_t)(t0 + row) * 1024 + hh * 128 + col) = ov;
  }
  __syncthreads();
}

DI void qproj_unit(const Params& p, int unit, char* smem) {
  const int tid = opaque_tid();
  const int mt = unit / 3, np = unit % 3;
  const u16* A = reinterpret_cast<const u16*>(p.ws + OFF_Z) + (size_t)mt * 128 * ZW + 1536;
  const u16* W = reinterpret_cast<const u16*>(p.ws + OFF_WQT) + (size_t)np * 256 * 256;
  float* rs = reinterpret_cast<float*>(smem + 65536 - 512);
  gemm_stage(A, ZW, W, 256, 0, smem, tid);
  float myrs;
  {
    const int row = tid >> 1, half = tid & 1;
    const u16* src = A + (size_t)row * ZW + half * 128;
    float ss = 0.f;
#pragma unroll
    for (int i = 0; i < 16; ++i) {
      bf16x8 v = *reinterpret_cast<const bf16x8*>(src + i * 8);
#pragma unroll
      for (int j = 0; j < 8; ++j) { float x = bf2f((u16)v[j]); ss += x * x; }
    }
    ss += __shfl_xor(ss, 1);
    myrs = rsqrtf(ss * (1.f / 256.f) + EPSF);
  }
#pragma unroll 1
  for (int h2 = 0; h2 < 2; ++h2) {
    f32x4 acc[4][4];
    gemm_mainloop(A, ZW, W + (size_t)h2 * 128 * 256, 256, 256, smem, acc, h2 == 0, tid);
    if ((tid & 1) == 0) rs[tid >> 1] = myrs;
    __syncthreads();
    store_tile_bf16(acc, smem, reinterpret_cast<u16*>(p.ws + OFF_Q) + (size_t)mt * 128 * 768 + (np * 2 + h2) * 128, 768, rs, tid);
  }
}

DI void kv_unit(const Params& p, int unit, char* smem) {
  const int tid = opaque_tid(), lane = tid & 63, wid = tid >> 6;
  const u16* Z = reinterpret_cast<const u16*>(p.ws + OFF_Z);
  const float* tc = reinterpret_cast<const float*>(p.ws + OFF_ROPE);
  const float* ts = tc + 2048 * 32;
  const float g0 = p.kv_norm_g[lane * 2], g1 = p.kv_norm_g[lane * 2 + 1];
  u16* tile = reinterpret_cast<u16*>(smem);
  const int t0 = unit * 64;
  const bool ctx = t0 < NCTX;
  const int b = ctx ? (t0 >> 8) : ((t0 - NCTX) >> 11), pos0 = ctx ? (t0 & 255) : ((t0 - NCTX) & 2047);
  const int ldv = ctx ? 256 : 2560;
  u16* Kb = ctx ? reinterpret_cast<u16*>(p.ws + OFF_KC) + (size_t)b * 256 * 192 : reinterpret_cast<u16*>(p.ws + OFF_KS) + (size_t)b * 2560 * 192;
  u16* VTb = ctx ? reinterpret_cast<u16*>(p.ws + OFF_VTC) + (size_t)b * 128 * 256 : reinterpret_cast<u16*>(p.ws + OFF_VTS) + (size_t)b * 128 * 2560;
  unsigned cvv[16]; u16 krv[16]; float csv[16], snv[16];
#pragma unroll
  for (int i = 0; i < 16; ++i) {
    const int tl = wid * 16 + i;
    const u16* zr = Z + (size_t)(t0 + tl) * ZW;
    cvv[i] = *reinterpret_cast<const unsigned*>(zr + 1792 + lane * 2);
    krv[i] = zr[1920 + lane];
    csv[i] = ctx ? 1.f : tc[(pos0 + tl) * 32 + (lane & 31)];
    snv[i] = ctx ? 0.f : ts[(pos0 + tl) * 32 + (lane & 31)];
  }
#pragma unroll
  for (int i = 0; i < 16; ++i) {
    const int tl = wid * 16 + i, t = t0 + tl, pos = pos0 + tl;
    float a0 = bf2f((u16)(cvv[i] & 0xffff)), a1 = bf2f((u16)(cvv[i] >> 16));
    float ss = a0 * a0 + a1 * a1;
#pragma unroll
    for (int o = 32; o > 0; o >>= 1) ss += __shfl_xor(ss, o);
    const float rstd = rsqrtf(ss * (1.f / 128.f) + EPSF);
    a0 *= rstd * g0; a1 *= rstd * g1;
    float kr = bf2f(krv[i]);
    if (ctx) {
      float* o_ckv = p.out + (size_t)NTOK * 1024 + (size_t)t * 128;
      float* o_kr = p.out + (size_t)NTOK * 1024 + (size_t)NCTX * 128 + (size_t)t * 64;
      *reinterpret_cast<float2*>(o_ckv + lane * 2) = make_float2(a0, a1);
      o_kr[lane] = kr;
    } else {
      float other = __shfl_xor(kr, 32);
      kr = (lane < 32) ? (kr * csv[i] - other * snv[i]) : (other * snv[i] + kr * csv[i]);
    }
    u16* Kd = Kb + (size_t)pos * 192;
    const unsigned pk = pack2(a0, a1);
    *reinterpret_cast<unsigned*>(Kd + lane * 2) = pk;
    Kd[128 + lane] = f2bf(kr);
  }
}

DI void phase_local(const Params& p, char* smem) {
  for (int u = blockIdx.x; u < 1440; u += gridDim.x) {
    if (u < 640) chunk_mlp_unit(p, u, smem);
    else if (u < 1120) qproj_unit(p, u - 640, smem);
    else kv_unit(p, u - 1120, smem);
  }
}

DI bf16x8 pack_step(const f32x16& x, int s) {
  u32x4 r;
  asm volatile("v_cvt_pk_bf16_f32 %0, %4, %5\n\tv_cvt_pk_bf16_f32 %1, %6, %7\n\tv_cvt_pk_bf16_f32 %2, %8, %9\n\tv_cvt_pk_bf16_f32 %3, %10, %11\n\ts_nop 1"
               : "=&v"(r[0]), "=&v"(r[1]), "=&v"(r[2]), "=&v"(r[3])
               : "v"(x[8 * s]), "v"(x[8 * s + 1]), "v"(x[8 * s + 2]), "v"(x[8 * s + 3]), "v"(x[8 * s + 4]), "v"(x[8 * s + 5]), "v"(x[8 * s + 6]), "v"(x[8 * s + 7]));
  return __builtin_bit_cast(bf16x8, r);
}

constexpr int AK_BYTES = 32 * 384;
constexpr int ASTAGE = AK_BYTES;

DI void attn_unit(const Params& p, int unit, char* smem) {
  const int tid = threadIdx.x, w = tid >> 6, lane = tid & 63, r = lane & 31, hf = lane >> 5;
  int t0, nkt, nrot, ldv, pos0;
  const u16 *Kg, *VTg;
  if (unit < 512) {
    const int b = unit & 7, g = unit >> 3;
    t0 = NCTX + b * 2048 + g * 32; nkt = 80; nrot = 64; ldv = 2560; pos0 = g * 32;
    Kg = reinterpret_cast<const u16*>(p.ws + OFF_KS) + (size_t)b * 2560 * 192;
    VTg = reinterpret_cast<const u16*>(p.ws + OFF_VTS) + (size_t)b * 128 * 2560;
  } else {
    const int u2 = unit - 512, b = (u2 & 7) + 8 * ((u2 >> 3) & 1), g = u2 >> 4;
    t0 = b * 256 + g * 32; nkt = 8; nrot = 0; ldv = 256; pos0 = 0;
    Kg = reinterpret_cast<const u16*>(p.ws + OFF_KC) + (size_t)b * 256 * 192;
    VTg = reinterpret_cast<const u16*>(p.ws + OFF_VTC) + (size_t)b * 128 * 256;
  }
  const u16* qrow = reinterpret_cast<const u16*>(p.ws + OFF_Q) + (size_t)(t0 + r) * 768 + w * 192;
  bf16x8 qa[8], qr[4];
#pragma unroll
  for (int s = 0; s < 8; ++s) qa[s] = *reinterpret_cast<const bf16x8*>(qrow + 16 * s + 8 * hf);
#pragma unroll
  for (int s = 0; s < 4; ++s) qr[s] = *reinterpret_cast<const bf16x8*>(qrow + 128 + 16 * s + 8 * hf);
  if (nrot > 0) {
    const float* tc = reinterpret_cast<const float*>(p.ws + OFF_ROPE) + (size_t)(pos0 + r) * 32;
    const float* ts = tc + 2048 * 32;
#pragma unroll
    for (int s = 0; s < 2; ++s) {
      bf16x8 n1, n2;
#pragma unroll
      for (int j = 0; j < 8; ++j) {
        float x1 = bf2f((u16)qr[s][j]), x2 = bf2f((u16)qr[s + 2][j]);
        float cs = tc[16 * s + 8 * hf + j], sn = ts[16 * s + 8 * hf + j];
        n1[j] = (short)f2bf(x1 * cs - x2 * sn);
        n2[j] = (short)f2bf(x1 * sn + x2 * cs);
      }
      qr[s] = n1; qr[s + 2] = n2;
    }
  }
  int kg0, kg1, kg2;
  {
    const int L0 = tid, L1 = tid + 256, L2 = tid + 512;
    const int r0 = L0 / 24, c0 = L0 % 24, r1 = L1 / 24, c1 = L1 % 24, r2 = L2 / 24, c2 = L2 % 24;
    kg0 = r0 * 192 + ((c0 & ~7) | ((c0 & 7) ^ ((r0 >> 1) & 7))) * 8;
    kg1 = r1 * 192 + ((c1 & ~7) | ((c1 & 7) ^ ((r1 >> 1) & 7))) * 8;
    kg2 = r2 * 192 + ((c2 & ~7) | ((c2 & 7) ^ ((r2 >> 1) & 7))) * 8;
  }
#define ATT_ISSUE(kt, stage) do { char* sb_ = smem + (stage) * ASTAGE + tid * 16; const u16* kb_ = Kg + (size_t)(kt) * 32 * 192; \
    __builtin_amdgcn_global_load_lds((const unsigned*)(kb_ + kg0), (unsigned*)(sb_), 16, 0, 0); \
    __builtin_amdgcn_global_load_lds((const unsigned*)(kb_ + kg1), (unsigned*)(sb_ + 4096), 16, 0, 0); \
    __builtin_amdgcn_global_load_lds((const unsigned*)(kb_ + kg2), (unsigned*)(sb_ + 8192), 16, 0, 0); } while (0)
  const int ksw = (r >> 1) & 7;
  int koff[4];
#pragma unroll
  for (int j = 0; j < 4; ++j) koff[j] = r * 384 + (((2 * j + hf) ^ ksw) * 16);
  int vtoff[2];
  {
    const int i16 = lane & 15, q4 = i16 >> 2, p4 = i16 & 3, blk = (lane >> 4) & 1;
    const int sw0 = (2 * hf + (q4 >> 1)) & 7;
#pragma unroll
    for (int dl = 0; dl < 2; ++dl) vtoff[dl] = (4 * hf + q4) * 384 + (((4 * dl + 2 * blk + (p4 >> 1)) ^ sw0) * 16) + 8 * (p4 & 1);
  }
  f32x16 o[4];
#pragma unroll
  for (int dt = 0; dt < 4; ++dt)
#pragma unroll
    for (int i = 0; i < 16; ++i) o[dt][i] = 0.f;
  float mrun = 0.f, lrun = 0.f;
  f32x16 negm;
#pragma unroll
  for (int i = 0; i < 16; ++i) negm[i] = 0.f;
  asm volatile("" :: "v"(qa[0]), "v"(qa[1]), "v"(qa[2]), "v"(qa[3]), "v"(qa[4]), "v"(qa[5]), "v"(qa[6]), "v"(qa[7]),
               "v"(qr[0]), "v"(qr[1]), "v"(qr[2]), "v"(qr[3]));
  asm volatile("s_waitcnt vmcnt(0)" ::: "memory");
  ATT_ISSUE(0, 0);
  ATT_ISSUE(1, 1);
  int st = 0;
  int t = 0;
#pragma unroll 1
  for (int seg = 0; seg < 2; ++seg) {
  const int tend = (seg == 0) ? nrot : nkt;
  if (seg == 1 && nrot > 0) {
#pragma unroll
    for (int s4 = 0; s4 < 4; ++s4) qr[s4] = *reinterpret_cast<const bf16x8*>(qrow + 128 + 16 * s4 + 8 * hf);
    asm volatile("" :: "v"(qr[0]), "v"(qr[1]), "v"(qr[2]), "v"(qr[3]));
  }
#pragma unroll 1
  for (; t < tend; ++t) {
    if (t + 1 < nkt) asm volatile("s_waitcnt vmcnt(3)" ::: "memory");
    else asm volatile("s_waitcnt vmcnt(0)" ::: "memory");
    __builtin_amdgcn_s_barrier();
    if (t + 2 < nkt) { const int st2 = (st == 0) ? 2 : st - 1; ATT_ISSUE(t + 2, st2); }
    const char* Ks = smem + st * ASTAGE;
    st = (st == 2) ? 0 : st + 1;
    f32x16 s;
    const unsigned kb = (unsigned)(size_t)Ks;
    const unsigned ka0 = kb + koff[0], ka1 = kb + koff[1], ka2 = kb + koff[2], ka3 = kb + koff[3];
    const unsigned va0 = kb + vtoff[0], va1 = kb + vtoff[1];
    {
      bf16x8 k0, k1, k2, k3, k4, k5, k6, k7, k8, k9, k10, k11;
      asm volatile(
          "ds_read_b128 %0, %12\n\tds_read_b128 %1, %13\n\tds_read_b128 %2, %14\n\tds_read_b128 %3, %15\n\t"
          "ds_read_b128 %4, %12 offset:128\n\tds_read_b128 %5, %13 offset:128\n\tds_read_b128 %6, %14 offset:128\n\tds_read_b128 %7, %15 offset:128\n\t"
          "ds_read_b128 %8, %12 offset:256\n\tds_read_b128 %9, %13 offset:256\n\tds_read_b128 %10, %14 offset:256\n\tds_read_b128 %11, %15 offset:256\n\t"
          "s_waitcnt lgkmcnt(0)"
          : "=&v"(k0), "=&v"(k1), "=&v"(k2), "=&v"(k3), "=&v"(k4), "=&v"(k5), "=&v"(k6), "=&v"(k7), "=&v"(k8), "=&v"(k9), "=&v"(k10), "=&v"(k11)
          : "v"(ka0), "v"(ka1), "v"(ka2), "v"(ka3) : "memory");
      __builtin_amdgcn_s_setprio(1);
      s = MFMA32(k0, qa[0], negm); s = MFMA32(k1, qa[1], s); s = MFMA32(k2, qa[2], s); s = MFMA32(k3, qa[3], s);
      s = MFMA32(k4, qa[4], s); s = MFMA32(k5, qa[5], s); s = MFMA32(k6, qa[6], s); s = MFMA32(k7, qa[7], s);
      s = MFMA32(k8, qr[0], s); s = MFMA32(k9, qr[1], s); s = MFMA32(k10, qr[2], s); s = MFMA32(k11, qr[3], s);
      __builtin_amdgcn_s_setprio(0);
    }
    s16x4 v0, v1, v2, v3, v4, v5, v6, v7, v8, v9, v10, v11, v12, v13, v14, v15;
    asm volatile(
        "ds_read_b64_tr_b16 %0, %16\n\tds_read_b64_tr_b16 %1, %17 offset:3072\n\tds_read_b64_tr_b16 %2, %16 offset:6144\n\tds_read_b64_tr_b16 %3, %17 offset:9216\n\t"
        "ds_read_b64_tr_b16 %4, %17\n\tds_read_b64_tr_b16 %5, %16 offset:3072\n\tds_read_b64_tr_b16 %6, %17 offset:6144\n\tds_read_b64_tr_b16 %7, %16 offset:9216\n\t"
        "ds_read_b64_tr_b16 %8, %16 offset:128\n\tds_read_b64_tr_b16 %9, %17 offset:3200\n\tds_read_b64_tr_b16 %10, %16 offset:6272\n\tds_read_b64_tr_b16 %11, %17 offset:9344\n\t"
        "ds_read_b64_tr_b16 %12, %17 offset:128\n\tds_read_b64_tr_b16 %13, %16 offset:3200\n\tds_read_b64_tr_b16 %14, %17 offset:6272\n\tds_read_b64_tr_b16 %15, %16 offset:9344"
        : "=&v"(v0), "=&v"(v1), "=&v"(v2), "=&v"(v3), "=&v"(v4), "=&v"(v5), "=&v"(v6), "=&v"(v7),
          "=&v"(v8), "=&v"(v9), "=&v"(v10), "=&v"(v11), "=&v"(v12), "=&v"(v13), "=&v"(v14), "=&v"(v15)
        : "v"(va0), "v"(va1) : "memory");
    const float mA = max3f_after_mfma(s[0], s[1], s[2]);
    float mx = max3f(max3f(mA, max3f(s[3], s[4], s[5]), max3f(s[6], s[7], s[8])),
                     max3f(s[9], s[10], s[11]), max3f(max3f(s[12], s[13], s[14]), s[15], s[15]));
    {
      auto sw = __builtin_amdgcn_permlane32_swap(__float_as_uint(mx), __float_as_uint(mx), false, false);
      mx = fmaxf(__uint_as_float(sw[0]), __uint_as_float(sw[1]));
    }
    const bool first = (t == 0);
    if (first || __builtin_amdgcn_ballot_w64(mx > 8.f) != 0ull) {
      const float delta = first ? mx : fmaxf(mx, 0.f);
      mrun += delta;
#pragma unroll
      for (int i = 0; i < 16; ++i) { negm[i] = -mrun; s[i] -= delta; }
      if (!first) {
        const float alpha = __builtin_amdgcn_exp2f(-delta);
        lrun *= alpha;
#pragma unroll
        for (int dt = 0; dt < 4; ++dt)
#pragma unroll
          for (int i = 0; i < 16; ++i) o[dt][i] *= alpha;
      }
    }
    f32x2_t ps2 = {0.f, 0.f};
#pragma unroll
    for (int i = 0; i < 8; ++i) {
      const float e0 = __builtin_amdgcn_exp2f(s[2 * i]), e1 = __builtin_amdgcn_exp2f(s[2 * i + 1]);
      s[2 * i] = e0; s[2 * i + 1] = e1;
      ps2 += f32x2_t{e0, e1};
    }
    lrun += ps2[0] + ps2[1];
    bf16x8 pb[2];
    pb[0] = pack_step(s, 0);
    pb[1] = pack_step(s, 1);
    asm volatile("s_waitcnt lgkmcnt(0)"
                 : "+v"(v0), "+v"(v1), "+v"(v2), "+v"(v3), "+v"(v4), "+v"(v5), "+v"(v6), "+v"(v7),
                   "+v"(v8), "+v"(v9), "+v"(v10), "+v"(v11), "+v"(v12), "+v"(v13), "+v"(v14), "+v"(v15));
    __builtin_amdgcn_s_setprio(1);
    o[0] = MFMA32(__builtin_shufflevector(v0, v1, 0, 1, 2, 3, 4, 5, 6, 7), pb[0], o[0]);
    o[1] = MFMA32(__builtin_shufflevector(v4, v5, 0, 1, 2, 3, 4, 5, 6, 7), pb[0], o[1]);
    o[2] = MFMA32(__builtin_shufflevector(v8, v9, 0, 1, 2, 3, 4, 5, 6, 7), pb[0], o[2]);
    o[3] = MFMA32(__builtin_shufflevector(v12, v13, 0, 1, 2, 3, 4, 5, 6, 7), pb[0], o[3]);
    o[0] = MFMA32(__builtin_shufflevector(v2, v3, 0, 1, 2, 3, 4, 5, 6, 7), pb[1], o[0]);
    o[1] = MFMA32(__builtin_shufflevector(v6, v7, 0, 1, 2, 3, 4, 5, 6, 7), pb[1], o[1]);
    o[2] = MFMA32(__builtin_shufflevector(v10, v11, 0, 1, 2, 3, 4, 5, 6, 7), pb[1], o[2]);
    o[3] = MFMA32(__builtin_shufflevector(v14, v15, 0, 1, 2, 3, 4, 5, 6, 7), pb[1], o[3]);
    __builtin_amdgcn_s_setprio(0);
  }
  }
  __syncthreads();
  lrun += __shfl_xor(lrun, 32);
  const float inv = 1.f / lrun;
#pragma unroll
  for (int dt = 0; dt < 4; ++dt)
#pragma unroll
    for (int i = 0; i < 16; ++i) o[dt][i] *= inv;
  int rr = r;
  asm volatile("" : "+v"(rr));
  const u16* wv = reinterpret_cast<const u16*>(p.ws + OFF_WKVT) + (size_t)(w * 256 + 128) * 128;
  f32x16 at[4];
#pragma unroll
  for (int n2 = 0; n2 < 4; ++n2)
#pragma unroll
    for (int i = 0; i < 16; ++i) at[n2][i] = 0.f;
#pragma unroll
  for (int dt = 0; dt < 4; ++dt)
#pragma unroll
    for (int s2 = 0; s2 < 2; ++s2) {
      const bf16x8 pb = pack_step(o[dt], s2);
#pragma unroll
      for (int n2 = 0; n2 < 4; ++n2) {
        const u16* wp = wv + (size_t)(32 * n2 + rr) * 128 + 32 * dt + 16 * s2 + 4 * hf;
        s16x4 lo = *reinterpret_cast<const s16x4*>(wp);
        s16x4 hi = *reinterpret_cast<const s16x4*>(wp + 8);
        bf16x8 wa = __builtin_shufflevector(lo, hi, 0, 1, 2, 3, 4, 5, 6, 7);
        at[n2] = MFMA32(wa, pb, at[n2]);
      }
    }
  const u16* gbr = reinterpret_cast<const u16*>(p.ws + OFF_Z) + (size_t)(t0 + rr) * ZW + 1984 + w * 128;
  u16* mrow = reinterpret_cast<u16*>(p.ws + OFF_H) + (size_t)(t0 + rr) * 1024 + 512 + w * 128;
#pragma unroll
  for (int n2 = 0; n2 < 4; ++n2)
#pragma unroll
    for (int g4 = 0; g4 < 4; ++g4) {
      const int n = 32 * n2 + 8 * g4 + 4 * hf;
      const s16x4 gb = *reinterpret_cast<const s16x4*>(gbr + n);
      uint2 v;
      v.x = pack2(at[n2][4 * g4] * silu_f(bf2f((u16)gb[0])), at[n2][4 * g4 + 1] * silu_f(bf2f((u16)gb[1])));
      v.y = pack2(at[n2][4 * g4 + 2] * silu_f(bf2f((u16)gb[2])), at[n2][4 * g4 + 3] * silu_f(bf2f((u16)gb[3])));
      *reinterpret_cast<uint2*>(mrow + n) = v;
    }
}

DI void phase_attn(const Params& p, char* smem) {
  for (int u = blockIdx.x; u < 640; u += gridDim.x) attn_unit(p, u, smem);
}

DI void phase_attnout(const Params& p, char* smem) {
  const int tid = threadIdx.x, wid = tid >> 6, lane = tid & 63, wr = wid >> 1, wc = wid & 1, fr = lane & 15, fq = lane >> 4;
  const u16* Z = reinterpret_cast<const u16*>(p.ws + OFF_Z);
  u16* MIX = reinterpret_cast<u16*>(p.ws + OFF_H);
  for (int u = blockIdx.x; u < 640; u += gridDim.x) {
    const int mt = u >> 2, hh = u & 3;
    const u16* A = reinterpret_cast<const u16*>(p.ws + OFF_OLAT) + (size_t)mt * 128 * 512 + hh * 128;
    const u16* W = reinterpret_cast<const u16*>(p.ws + OFF_WKVT) + (size_t)(hh * 256 + 128) * 128;
    f32x4 acc[4][4];
    gemm_mainloop(A, 512, W, 128, 128, smem, acc);
#pragma unroll
    for (int m = 0; m < 4; ++m)
#pragma unroll
      for (int j = 0; j < 4; ++j) {
        const int t = mt * 128 + wr * 64 + m * 16 + fq * 4 + j;
#pragma unroll
        for (int n = 0; n < 4; ++n) {
          const int col = hh * 128 + wc * 64 + n * 16 + fr;
          float gb = silu_f(bf2f(Z[(size_t)t * ZW + 1984 + col]));
          MIX[(size_t)t * 1024 + 512 + col] = f2bf(acc[m][n][j] * gb);
        }
      }
  }
}

DI void phase_out(const Params& p, char* smem) {
  const int tid = threadIdx.x, wid = tid >> 6, lane = tid & 63, wr = wid >> 1, wc = wid & 1, fr = lane & 15, fq = lane >> 4;
  const u16* MIX = reinterpret_cast<const u16*>(p.ws + OFF_H);
  const u16* W = reinterpret_cast<const u16*>(p.ws + OFF_WOT);
  const float* mod = reinterpret_cast<const float*>(p.ws + OFF_MOD);
  float* SS = reinterpret_cast<float*>(p.ws + OFF_SS);
  u16* R = reinterpret_cast<u16*>(p.ws + OFF_Z);
  for (int u = blockIdx.x; u < 160 * 8; u += gridDim.x) {
    const int xcd = u & 7, iu = u >> 3;
    const int mt = (iu >> 3) * 8 + xcd, nt = iu & 7;
    f32x4 acc[4][4];
    gemm_mainloop(MIX + (size_t)mt * 128 * 1024, 1024, W + (size_t)nt * 128 * 1024, 1024, 1024, smem, acc);
    const float* gate = mod + cond_of(mt * 128) * 3072 + 2048 + nt * 128;
    const int col = (tid & 31) * 4;
    float4 xv[16];
#pragma unroll
    for (int i = 0; i < 16; ++i) xv[i] = *reinterpret_cast<const float4*>(xrow(p, mt * 128 + (tid >> 5) + i * 8) + nt * 128 + col);
    const float4 g4 = *reinterpret_cast<const float4*>(gate + col);
    float* stf = reinterpret_cast<float*>(smem);
#pragma unroll
    for (int m = 0; m < 4; ++m)
#pragma unroll
      for (int j = 0; j < 4; ++j) {
        const int row = wr * 64 + m * 16 + fq * 4 + j;
#pragma unroll
        for (int n = 0; n < 4; ++n) stf[row * 128 + ((wc * 64 + n * 16 + fr) ^ (fq * 16))] = acc[m][n][j];
      }
    __syncthreads();
#pragma unroll
    for (int i = 0; i < 16; ++i) {
      const int row = (tid >> 5) + i * 8, sw = ((row >> 2) & 3) * 16, t = mt * 128 + row;
      const float4 y = *reinterpret_cast<const float4*>(stf + row * 128 + (col ^ sw));
      float4 rv;
      rv.x = xv[i].x + g4.x * y.x; rv.y = xv[i].y + g4.y * y.y; rv.z = xv[i].z + g4.z * y.z; rv.w = xv[i].w + g4.w * y.w;
      *reinterpret_cast<uint2*>(R + (size_t)t * 1024 + nt * 128 + col) = make_uint2(pack2(rv.x, rv.y), pack2(rv.z, rv.w));
      float ss = rv.x * rv.x + rv.y * rv.y + rv.z * rv.z + rv.w * rv.w;
#pragma unroll
      for (int o = 16; o > 0; o >>= 1) ss += __shfl_xor(ss, o);
      if ((tid & 31) == 0) SS[(size_t)t * 16 + nt] = ss;
    }
    __syncthreads();
  }
}

DI void phase_final(const Params& p) {
  const int lane = threadIdx.x & 63, wid = threadIdx.x >> 6;
  const float* SS = reinterpret_cast<const float*>(p.ws + OFF_SS);
  const u16* R = reinterpret_cast<const u16*>(p.ws + OFF_Z);
  float4 g[4];
#pragma unroll
  for (int j = 0; j < 4; ++j) g[j] = *reinterpret_cast<const float4*>(p.final_g + j * 256 + lane * 4);
  for (int t = (blockIdx.x * 4 + wid) * 4; t < NTOK; t += gridDim.x * 16) {
    uint2 rb[4][4];
    float ssv[4];
#pragma unroll
    for (int k = 0; k < 4; ++k) {
      ssv[k] = (lane < 8) ? SS[(size_t)(t + k) * 16 + lane] : 0.f;
#pragma unroll
      for (int j = 0; j < 4; ++j) rb[k][j] = *reinterpret_cast<const uint2*>(R + (size_t)(t + k) * 1024 + j * 256 + lane * 4);
    }
#pragma unroll
    for (int k = 0; k < 4; ++k) {
      float ss = ssv[k];
#pragma unroll
      for (int o = 4; o > 0; o >>= 1) ss += __shfl_xor(ss, o);
      ss = __shfl(ss, 0);
      const float rstd = rsqrtf(ss * (1.f / 1024.f) + EPSF);
      float* row = p.out + (size_t)(t + k) * 1024;
#pragma unroll
      for (int j = 0; j < 4; ++j) {
        float4 v;
        v.x = bf2f((u16)(rb[k][j].x & 0xffff)) * rstd * g[j].x; v.y = bf2f((u16)(rb[k][j].x >> 16)) * rstd * g[j].y;
        v.z = bf2f((u16)(rb[k][j].y & 0xffff)) * rstd * g[j].z; v.w = bf2f((u16)(rb[k][j].y >> 16)) * rstd * g[j].w;
        *reinterpret_cast<float4*>(row + j * 256 + lane * 4) = v;
      }
    }
  }
}

#define XB_TMO      128
#define XB_XCNT(j)  (256  + 64 * (j))
#define XB_XSUB(j)  (1280 + 64 * (j))
#define XB_XGEN(j)  (2304 + 64 * (j))
#define XB_TOP      3328
#define XB_TOPGEN   3392
#define XB_SPIN_CAP (1u << 22)
DI unsigned xb_ld(unsigned* p) { return __hip_atomic_load(p, __ATOMIC_RELAXED, __HIP_MEMORY_SCOPE_AGENT); }
DI unsigned xb_add(unsigned* p, unsigned v) { return __hip_atomic_fetch_add(p, v, __ATOMIC_RELAXED, __HIP_MEMORY_SCOPE_AGENT); }
DI unsigned xb_xcc_id() { return (unsigned)__builtin_amdgcn_s_getreg((3 << 11) | 20) & 0xFu; }
#define XB_SPIN(cond, bar) do { unsigned _sp = 0; while (cond) { __builtin_amdgcn_s_sleep(1); \
    if ((++_sp & 255u) == 0u) { if (xb_ld(&(bar)[XB_TMO])) break; if (_sp > XB_SPIN_CAP) { atomicAdd(&(bar)[XB_TMO], 1u); break; } } } } while (0)
struct XcdBarrier { unsigned* bar; unsigned x, nloc, nx; };
DI void xcd_barrier_post(XcdBarrier& b, unsigned* bar) {
  b.bar = bar; b.x = xb_xcc_id(); b.nloc = 0u; b.nx = 0u;
  if (threadIdx.x == 0) (void)xb_add(&bar[XB_XCNT(b.x)], 1u);
}
DI void xcd_barrier_complete(unsigned* bar, unsigned x, unsigned& nloc, unsigned& nx) {
  const unsigned G = gridDim.x;
  unsigned sum, cnt, mine, sp = 0u;
  for (;;) {
    sum = 0u; cnt = 0u; mine = 0u;
#pragma unroll
    for (unsigned j = 0; j < 16; ++j) { const unsigned c = xb_ld(&bar[XB_XCNT(j)]); sum += c; cnt += (c > 0u) ? 1u : 0u; mine = (j == x) ? c : mine; }
    if (sum == G) break;
    __builtin_amdgcn_s_sleep(1);
    if ((++sp & 255u) == 0u) { if (xb_ld(&bar[XB_TMO])) break; if (sp > XB_SPIN_CAP) { atomicAdd(&bar[XB_TMO], 1u); break; } }
  }
  nloc = mine > 0u ? mine : 1u; nx = cnt > 0u ? cnt : 1u;
}
DI void xcd_barrier(XcdBarrier& b) {
  asm volatile("s_waitcnt vmcnt(0)" ::: "memory");
  __syncthreads();
  if (threadIdx.x == 0) {
    unsigned* bar = b.bar;
    __builtin_amdgcn_s_waitcnt(0);
    if (b.nloc == 0u) xcd_barrier_complete(bar, b.x, b.nloc, b.nx);
    const unsigned nloc = b.nloc, nx = b.nx;
    const unsigned old = xb_add(&bar[XB_XSUB(b.x)], 1u);
    const unsigned gen = old / nloc;
    if (old + 1u == (gen + 1u) * nloc) {
      __builtin_amdgcn_fence(__ATOMIC_RELEASE, "agent");
      asm volatile("s_waitcnt vmcnt(0)" ::: "memory");
      const unsigned og = xb_add(&bar[XB_TOP], 1u);
      const unsigned tg = og / nx;
      if (og + 1u == (tg + 1u) * nx) xb_add(&bar[XB_TOPGEN], 1u);
      else XB_SPIN(xb_ld(&bar[XB_TOPGEN]) == tg, bar);
      __builtin_amdgcn_fence(__ATOMIC_ACQUIRE, "agent");
      xb_add(&bar[XB_XGEN(b.x)], 1u);
      asm volatile("s_waitcnt vmcnt(0)" ::: "memory");
    } else {
      XB_SPIN(xb_ld(&bar[XB_XGEN(b.x)]) == gen, bar);
      __builtin_amdgcn_fence(__ATOMIC_ACQUIRE, "agent");
      asm volatile("s_waitcnt vmcnt(0)" ::: "memory");
    }
  }
  __syncthreads();
}

typedef const __attribute__((address_space(4))) Params* KargPtr;
DI Params load_params() {
#if defined(__HIP_DEVICE_COMPILE__)
  KargPtr pp = (KargPtr)__builtin_amdgcn_kernarg_segment_ptr();
  asm volatile("" : "+s"(pp));
  Params r;
  r.x_prompt = pp->x_prompt;
  r.x_sample = pp->x_sample;
  r.cache_ckv = pp->cache_ckv;
  r.cache_krope = pp->cache_krope;
  r.c = pp->c;
  r.c_ctx = pp->c_ctx;
  r.norm_g = pp->norm_g;
  r.w_ada = pp->w_ada;
  r.b_ada = pp->b_ada;
  r.w_in = pp->w_in;
  r.w_s = pp->w_s;
  r.b_s = pp->b_s;
  r.g_v = pp->g_v;
  r.q_norm_g = pp->q_norm_g;
  r.w_uq = pp->w_uq;
  r.kv_norm_g = pp->kv_norm_g;
  r.w_ukv = pp->w_ukv;
  r.w_o = pp->w_o;
  r.final_g = pp->final_g;
  r.out = pp->out;
  r.ws = pp->ws;
  return r;
#else
  return Params{};
#endif
}

template <int LO, int HI>
__global__ void __launch_bounds__(NT, 2) fwd_kernel(Params p_in) {
  __shared__ __attribute__((aligned(16))) char smem[65536];
  XcdBarrier xb;
  if constexpr (LO < HI) {
    const Params p = load_params();
    xcd_barrier_post(xb, reinterpret_cast<unsigned*>(p.ws + OFF_BAR));
    if (p.out == nullptr) cg::this_grid().sync();
  }
#ifndef REP_PHASE
#define REP_PHASE -1
#endif
#define PHASE(N, CALL) if constexpr (LO <= N && N <= HI) { { const Params p = load_params(); CALL; if constexpr (N == REP_PHASE && LO < HI) { CALL; } } if constexpr (N < HI) xcd_barrier(xb); }
  PHASE(0, phase_prep(p, smem))
  PHASE(1, phase_h(p))
  PHASE(2, phase_gemm1(p, smem))
  PHASE(3, phase_local(p, smem))
  PHASE(4, phase_attn(p, smem))
  PHASE(5, phase_out(p, smem))
  PHASE(6, phase_final(p))
}

template __global__ void fwd_kernel<2, 2>(Params);

extern "C" void kernel_launch(void* const* d_in, const int* in_sizes, int n_in, void* d_out, int out_size, void* d_ws,
                              size_t ws_size, hipStream_t stream) {
  Params p{};
  p.x_prompt = (const float*)d_in[0]; p.x_sample = (const float*)d_in[1]; p.cache_ckv = (const float*)d_in[2];
  p.cache_krope = (const float*)d_in[3]; p.c = (const float*)d_in[4]; p.c_ctx = (const float*)d_in[5];
  p.norm_g = (const float*)d_in[6]; p.w_ada = (const float*)d_in[7]; p.b_ada = (const float*)d_in[8];
  p.w_in = (const float*)d_in[9]; p.w_s = (const float*)d_in[10]; p.b_s = (const float*)d_in[11];
  p.g_v = (const float*)d_in[12]; p.q_norm_g = (const float*)d_in[13]; p.w_uq = (const float*)d_in[14];
  p.kv_norm_g = (const float*)d_in[15]; p.w_ukv = (const float*)d_in[16]; p.w_o = (const float*)d_in[17];
  p.final_g = (const float*)d_in[18];
  p.out = (float*)d_out;
  p.ws = (char*)d_ws;
  if (ws_size < WS_TOTAL) { fprintf(stderr, "workspace too small: %zu < %zu\n", ws_size, WS_TOTAL); return; }
#if 0
  hipLaunchKernelGGL((fwd_kernel<0, 0>), dim3(512), dim3(NT), 0, stream, p);
  hipLaunchKernelGGL((fwd_kernel<1, 1>), dim3(512), dim3(NT), 0, stream, p);
  hipLaunchKernelGGL((fwd_kernel<2, 2>), dim3(512), dim3(NT), 0, stream, p);
  hipLaunchKernelGGL((fwd_kernel<3, 3>), dim3(512), dim3(NT), 0, stream, p);
  hipLaunchKernelGGL((fwd_kernel<4, 4>), dim3(512), dim3(NT), 0, stream, p);
  hipLaunchKernelGGL((fwd_kernel<5, 5>), dim3(512), dim3(NT), 0, stream, p);
  hipLaunchKernelGGL((fwd_kernel<6, 6>), dim3(512), dim3(NT), 0, stream, p);
  hipLaunchKernelGGL((fwd_kernel<7, 7>), dim3(512), dim3(NT), 0, stream, p);
#else
  static int grid_blocks = 0;
  if (!grid_blocks) {
    int dev = 0, cus = 0, per_cu = 0;
    hipGetDevice(&dev);
    hipDeviceGetAttribute(&cus, hipDeviceAttributeMultiprocessorCount, dev);
    hipOccupancyMaxActiveBlocksPerMultiprocessor(&per_cu, fwd_kernel<0, 6>, NT, 0);
    if (per_cu > 2) per_cu = 2;
    grid_blocks = cus * per_cu;
  }
  hipMemsetAsync((char*)d_ws + OFF_BAR, 0, (3456 + 256) * 4, stream);
  void* args[] = {&p};
  hipError_t e = hipLaunchCooperativeKernel((void*)fwd_kernel<0, 6>, dim3(grid_blocks), dim3(NT), args, 0, stream);
  if (e != hipSuccess) fprintf(stderr, "cooperative launch failed: %s (grid %d)\n", hipGetErrorString(e), grid_blocks);
#endif
}
```
